# Optimizing an MI355X kernel written in HIP

```python
import jax, jax.numpy as jnp
from jax import lax
import numpy as np

D_MODEL = 2048
BATCH = 4
SEQ = 4096
DEPTH = 2

GRID_W = 64
CTX_LEN = 256
N_MIXERS = 2
N_HEADS = 16
N_KV_HEADS = 4
HEAD_DIM = D_MODEL // N_HEADS
KV_GROUP = N_HEADS // N_KV_HEADS
KV_DIM = N_KV_HEADS * HEAD_DIM
QKV_DIM = D_MODEL + 2 * KV_DIM
ROPE_THETA = 10000.0
Q_BLOCK = 128
N_FOURIER_GROUPS = 8
FOURIER_GROUP_DIM = D_MODEL // N_FOURIER_GROUPS
D_FF = 4 * D_MODEL
N_MOD = 6
EPS = 1e-6
N_ATTN_LAYERS = (DEPTH + N_MIXERS - 1) // N_MIXERS
N_FOURIER_LAYERS = DEPTH // N_MIXERS

kernel_name = "hybrid_gqa_fourier_dit_block"


def rms_norm(x, g):
    xf = x.astype(jnp.float32)
    y = xf * lax.rsqrt(jnp.mean(xf * xf, axis=-1, keepdims=True) + EPS)
    return (y * g.astype(jnp.float32)).astype(x.dtype)


def modulate(h, shift, scale):
    return h * (1 + scale) + shift


def axial_rope_angles(n_tokens):
    rows = n_tokens // GRID_W
    row = jnp.broadcast_to(jnp.arange(rows)[:, None], (rows, GRID_W)).reshape(-1)
    col = jnp.broadcast_to(jnp.arange(GRID_W)[None, :], (rows, GRID_W)).reshape(-1)
    n_freq = HEAD_DIM // 4
    inv_freq = ROPE_THETA ** (-jnp.arange(n_freq, dtype=jnp.float32) / n_freq)
    ang = jnp.concatenate([row.astype(jnp.float32)[:, None] * inv_freq,
                           col.astype(jnp.float32)[:, None] * inv_freq], axis=-1)
    return jnp.cos(ang), jnp.sin(ang)


def apply_rope(x, cos, sin):
    xp = x.astype(jnp.float32).reshape(x.shape[:-1] + (HEAD_DIM // 2, 2))
    x0, x1 = xp[..., 0], xp[..., 1]
    c = cos[None, :, None, :]
    s = sin[None, :, None, :]
    out = jnp.stack([x0 * c - x1 * s, x0 * s + x1 * c], axis=-1)
    return out.reshape(x.shape).astype(x.dtype)


def project_kv(h, w_kv, k_gain):
    b, n, _ = h.shape
    kv = h @ w_kv
    k, v = jnp.split(kv, 2, axis=-1)
    k = rms_norm(k.reshape(b, n, N_KV_HEADS, HEAD_DIM), k_gain)
    v = v.reshape(b, n, N_KV_HEADS, HEAD_DIM)
    return k, v


def project_qkv(h, w_qkv, q_gain, k_gain):
    b, n, _ = h.shape
    q = rms_norm((h @ w_qkv[:, :D_MODEL]).reshape(b, n, N_HEADS, HEAD_DIM), q_gain)
    k, v = project_kv(h, w_qkv[:, D_MODEL:], k_gain)
    return q, k, v


def latent_attention(q_lat, k_lat, v_lat, k_ctx, v_ctx):
    b, s = q_lat.shape[:2]
    n_blocks = s // Q_BLOCK
    qb = jnp.moveaxis(q_lat.reshape(b, n_blocks, Q_BLOCK, N_KV_HEADS, KV_GROUP, HEAD_DIM), 1, 0)
    scale = HEAD_DIM ** -0.5

    def one_block(q):
        logits = jnp.concatenate([
            jnp.einsum('bqkgd,bskd->bkgqs', q, k_lat),
            jnp.einsum('bqkgd,bskd->bkgqs', q, k_ctx)], axis=-1).astype(jnp.float32) * scale
        p = jax.nn.softmax(logits, axis=-1).astype(v_lat.dtype)
        return (jnp.einsum('bkgqs,bskd->bqkgd', p[..., :s], v_lat)
                + jnp.einsum('bkgqs,bskd->bqkgd', p[..., s:], v_ctx))

    o = lax.map(one_block, qb)
    return jnp.moveaxis(o, 0, 1).reshape(b, s, D_MODEL)


def context_attention(q_ctx, k_ctx, v_ctx):
    b, l = q_ctx.shape[:2]
    q = q_ctx.reshape(b, l, N_KV_HEADS, KV_GROUP, HEAD_DIM)
    logits = jnp.einsum('bqkgd,bskd->bkgqs', q, k_ctx).astype(jnp.float32) * (HEAD_DIM ** -0.5)
    p = jax.nn.softmax(logits, axis=-1).astype(v_ctx.dtype)
    return jnp.einsum('bkgqs,bskd->bqkgd', p, v_ctx).reshape(b, l, D_MODEL)


def fourier_mix(h, w_o):
    b, n, _ = h.shape
    hg = h.astype(jnp.float32).reshape(b, n, N_FOURIER_GROUPS, FOURIER_GROUP_DIM)
    y = jnp.fft.fftn(hg, axes=(1, 3), norm="ortho").real
    return y.reshape(b, n, D_MODEL).astype(h.dtype) @ w_o


def sq_relu_mlp(h, w1, w2):
    return jnp.square(jax.nn.relu(h @ w1)) @ w2


def setup_inputs(seed: int = 0) -> dict:
    key = jax.random.key(seed)
    ks = jax.random.split(key, 16)
    f32 = jnp.float32

    def normal(k, shape, std):
        return jax.random.normal(k, shape, f32) * std

    return {
        "x": normal(ks[0], (BATCH, SEQ, D_MODEL), 1.0),
        "c": normal(ks[1], (BATCH, D_MODEL), 1.0),
        "ctx": normal(ks[2], (BATCH, CTX_LEN, D_MODEL), 1.0),
        "c_ctx": normal(ks[3], (D_MODEL,), 1.0),
        "ada_w": normal(ks[4], (DEPTH, D_MODEL, N_MOD * D_MODEL), 0.02),
        "ada_b": normal(ks[5], (DEPTH, N_MOD * D_MODEL), 0.05),
        "norm_mix_g": 1.0 + normal(ks[6], (DEPTH, D_MODEL), 0.02),
        "norm_mlp_g": 1.0 + normal(ks[7], (DEPTH, D_MODEL), 0.02),
        "attn_w_qkv": normal(ks[8], (N_ATTN_LAYERS, D_MODEL, QKV_DIM), D_MODEL ** -0.5),
        "attn_q_norm_g": 1.0 + normal(ks[9], (N_ATTN_LAYERS, HEAD_DIM), 0.02),
        "attn_k_norm_g": 1.0 + normal(ks[10], (N_ATTN_LAYERS, HEAD_DIM), 0.02),
        "attn_w_o": normal(ks[11], (N_ATTN_LAYERS, D_MODEL, D_MODEL), D_MODEL ** -0.5),
        "fourier_w_o": normal(ks[12], (N_FOURIER_LAYERS, D_MODEL, D_MODEL), D_MODEL ** -0.5),
        "mlp_w1": normal(ks[13], (DEPTH, D_MODEL, D_FF), D_MODEL ** -0.5),
        "mlp_w2": normal(ks[14], (DEPTH, D_FF, D_MODEL), D_FF ** -0.5),
        "final_norm_g": 1.0 + normal(ks[15], (D_MODEL,), 0.02),
    }


def reference(x, c, ctx, c_ctx, ada_w, ada_b, norm_mix_g, norm_mlp_g, attn_w_qkv, attn_q_norm_g,
              attn_k_norm_g, attn_w_o, fourier_w_o, mlp_w1, mlp_w2, final_norm_g):
    cos, sin = axial_rope_angles(x.shape[1])
    silu_c = jax.nn.silu(c)
    silu_cc = jax.nn.silu(c_ctx)
    for i in range(DEPTH):
        mixer = i % N_MIXERS
        j = i // N_MIXERS
        ctx_read_later = any(l % N_MIXERS == 0 for l in range(i + 1, DEPTH))
        mod_lat = (silu_c @ ada_w[i] + ada_b[i])[:, None, :]
        sh1, sc1, g1, sh2, sc2, g2 = jnp.split(mod_lat, N_MOD, axis=-1)
        mod_ctx = silu_cc @ ada_w[i] + ada_b[i]
        csh1, csc1, cg1, csh2, csc2, cg2 = jnp.split(mod_ctx, N_MOD, axis=-1)

        h_lat = modulate(rms_norm(x, norm_mix_g[i]), sh1, sc1)
        if mixer == 0 or ctx_read_later:
            h_ctx = modulate(rms_norm(ctx, norm_mix_g[i]), csh1, csc1)

        if mixer == 0:
            q_l, k_l, v_l = project_qkv(h_lat, attn_w_qkv[j], attn_q_norm_g[j], attn_k_norm_g[j])
            q_l = apply_rope(q_l, cos, sin)
            k_l = apply_rope(k_l, cos, sin)
            if ctx_read_later:
                q_c, k_c, v_c = project_qkv(h_ctx, attn_w_qkv[j], attn_q_norm_g[j], attn_k_norm_g[j])
                o_ctx = context_attention(q_c, k_c, v_c) @ attn_w_o[j]
            else:
                k_c, v_c = project_kv(h_ctx, attn_w_qkv[j][:, D_MODEL:], attn_k_norm_g[j])
            o_lat = latent_attention(q_l, k_l, v_l, k_c, v_c) @ attn_w_o[j]
        else:
            o_lat = fourier_mix(h_lat, fourier_w_o[j])
            if ctx_read_later:
                o_ctx = fourier_mix(h_ctx, fourier_w_o[j])

        x = x + g1 * o_lat
        x = x + g2 * sq_relu_mlp(modulate(rms_norm(x, norm_mlp_g[i]), sh2, sc2), mlp_w1[i], mlp_w2[i])
        if ctx_read_later:
            ctx = ctx + cg1 * o_ctx
            ctx = ctx + cg2 * sq_relu_mlp(modulate(rms_norm(ctx, norm_mlp_g[i]), csh2, csc2),
                                          mlp_w1[i], mlp_w2[i])
    return rms_norm(x, final_norm_g)
```

```cpp
#include <hip/hip_runtime.h>
#include <hip/hip_cooperative_groups.h>
#include <cstdio>
#include <cstdint>
namespace cg = cooperative_groups;

#ifndef MK_MULTI_LAUNCH
#define MK_MULTI_LAUNCH 0
#endif

#define LAS __attribute__((address_space(3)))
typedef unsigned short bf16_t;
typedef short bf16x8 __attribute__((ext_vector_type(8)));
typedef short s16x4 __attribute__((ext_vector_type(4)));
typedef float f32x4 __attribute__((ext_vector_type(4)));
typedef float f32x2 __attribute__((ext_vector_type(2)));
typedef float f32x16 __attribute__((ext_vector_type(16)));
typedef unsigned u32x4 __attribute__((ext_vector_type(4)));
typedef unsigned u32x2 __attribute__((ext_vector_type(2)));

constexpr int DM = 2048, NB = 4, SEQ = 4096, CTXL = 256, NH = 16, NKV = 4, HD = 128, KVD = NKV * HD, QKVD = DM + 2 * KVD, DFF = 8192;
constexpr int MLAT = NB * SEQ, MCTX = NB * CTXL, MALL = MLAT + MCTX, SKV = SEQ + CTXL, NMOD = 6 * DM;
constexpr float EPS = 1e-6f;
constexpr int NPHASE = 17;

constexpr size_t MiB = 1u << 20;
constexpr size_t WS_MOD = 1 * MiB;
constexpr size_t WS_ROPE = WS_MOD + 512 * 1024;
constexpr size_t WS_C256 = WS_ROPE + 64 * 1024;
constexpr size_t WS_S256 = WS_C256 + 128 * 1024;
constexpr size_t WS_HNY = WS_S256 + 128 * 1024;
constexpr size_t WS_ZFIX = WS_HNY + 32 * 1024;
constexpr size_t WS_WQKV = 4 * MiB, WS_WO = 16 * MiB, WS_WF = 24 * MiB, WS_W1A = 32 * MiB, WS_W2A = 64 * MiB, WS_W1B = 96 * MiB, WS_W2B = 128 * MiB;
constexpr size_t WS_T = 160 * MiB;
constexpr size_t WS_H = 192 * MiB;
constexpr size_t WS_ACT = 260 * MiB;
constexpr size_t WS_Q = WS_ACT, WS_K = WS_ACT + 64 * MiB, WS_V = WS_K + 17 * MiB, WS_O = WS_V + 17 * MiB;
constexpr size_t WS_K8 = WS_ACT + 164 * MiB, WS_V8 = WS_ACT + 174 * MiB;
constexpr size_t WS_U = WS_ACT, WS_ZT = WS_ACT + 64 * MiB, WS_Y = WS_ACT + 128 * MiB, WS_PT = WS_ACT + 192 * MiB;
constexpr size_t WS_XB = WS_ACT + 256 * MiB;
constexpr size_t WS_END = WS_XB + 64 * MiB;
static_assert(WS_ZFIX + 32 * 1024 <= WS_WQKV && WS_O + 64 * MiB <= WS_END && WS_Y + 64 * MiB <= WS_END, "ws map");

constexpr int LDS_BYTES = 147456;
constexpr int LDS_MISC = 139264;
constexpr size_t WS_CTL = 0, CTL_ZERO_BYTES = 16384;

__device__ __forceinline__ unsigned f2bf(float f) { unsigned u = __builtin_bit_cast(unsigned, f); return (u + 0x7fffu + ((u >> 16) & 1u)) >> 16; }
__device__ __forceinline__ unsigned cvt_pk_bf16(float lo, float hi) { unsigned r; asm volatile("v_cvt_pk_bf16_f32 %0, %1, %2" : "=v"(r) : "v"(lo), "v"(hi)); return r; }
__device__ __forceinline__ unsigned pk2(float lo, float hi) { unsigned r; asm("v_cvt_pk_bf16_f32 %0, %1, %2" : "=v"(r) : "v"(lo), "v"(hi)); return r; }
__device__ __forceinline__ float bf_lo(unsigned w) { return __builtin_bit_cast(float, w << 16); }
__device__ __forceinline__ float bf_hi(unsigned w) { return __builtin_bit_cast(float, w & 0xffff0000u); }
__device__ __forceinline__ unsigned pk4_fp8g(float a, float b, float c, float d) { unsigned w;
    asm("v_cvt_pk_fp8_f32 %0, %1, %2" : "=v"(w) : "v"(a), "v"(b)); asm("v_cvt_pk_fp8_f32 %0, %1, %2 op_sel:[0,0,1]" : "+v"(w) : "v"(c), "v"(d)); return w; }
__device__ __forceinline__ float wave_sum(float v) {
#pragma unroll
    for (int o = 1; o < 64; o <<= 1) v += __shfl_xor(v, o);
    return v;
}

namespace pg8 {
constexpr int BM = 256, BK = 64, HALF = 128, HTB = HALF * BK * 2, STAGE_BYTES = 8 * HTB, NXCD = 8, WGM = 8;
__host__ __device__ __forceinline__ int lds_byte(int r, int c) { const int st = (r >> 4) * 2 + (c >> 5), rr = r & 15, cc = c & 31, ob = rr * 64 + cc * 2; return st * 1024 + (ob ^ (((ob >> 9) & 1) << 5)); }
__host__ __device__ __forceinline__ void stage_rc(int b, int& R, int& C) { const int st = b / 1024, sb = b % 1024, swz = sb ^ (((sb >> 9) & 1) << 5); R = (st >> 1) * 16 + swz / 64; C = (st & 1) * 32 + (swz % 64) / 2; }
__host__ __device__ __forceinline__ int perm32(int rho) { const int n = rho >> 4, i = rho & 15; return 8 * (i >> 2) + 4 * n + (i & 3); }

struct Unit { const char* a; const char* b; int orow, ocol, sel, aux; };

__device__ __forceinline__ void tile_map(int wgid, int nM, int nN, int& pm, int& pn, const int WGM = 8) {
    const int nwg = nM * nN;
    { const int q = nwg / NXCD, r = nwg % NXCD, xcd = wgid % NXCD, off = wgid / NXCD; wgid = (xcd < r ? xcd * (q + 1) : r * (q + 1) + (xcd - r) * q) + off; }
    const int nig = WGM * nN, gid = wgid / nig, fm = gid * WGM, gsz = (nM - fm) < WGM ? (nM - fm) : WGM;
    pm = fm + ((wgid % nig) % gsz); pn = (wgid % nig) / gsz;
}

typedef int v8i_t __attribute__((ext_vector_type(8)));
typedef int v4i_t __attribute__((ext_vector_type(4)));
__device__ __forceinline__ v8i_t cat8(bf16x8 lo, bf16x8 hi) { const v4i_t a = __builtin_bit_cast(v4i_t, lo), b = __builtin_bit_cast(v4i_t, hi); v8i_t r; r[0] = a.x; r[1] = a.y; r[2] = a.z; r[3] = a.w; r[4] = b.x; r[5] = b.y; r[6] = b.z; r[7] = b.w; return r; }
template <bool FP8, int WSC, int ASC, class Epi, class Sched>
__device__ __forceinline__ void gemm_phase_t(LAS unsigned char* lds, const int nt, const int ldaB, const int ldbB, const Sched& S, const Epi& E) {
    int tid_o = threadIdx.x; asm volatile("" : "+v"(tid_o));
    const int tid = tid_o, wid = __builtin_amdgcn_readfirstlane(tid >> 6), lane = tid & 63, wr = wid >> 2, wc = wid & 3, fr = lane & 15, fq = lane >> 4;
    unsigned voffA[2], voffB[2];
#pragma unroll
    for (int i = 0; i < 2; ++i) { int R, C; stage_rc(tid * 16 + i * 8192, R, C); const int Rb = Epi::PERM ? ((R & ~31) + perm32(R & 31)) : R;
        voffA[i] = (unsigned)(R * ldaB + C * 2); voffB[i] = (unsigned)(Rb * ldbB + C * 2); }
    const size_t kstep = (size_t)(BK * 2);
    const size_t hstepA = (size_t)HALF * ldaB, hstepB = (size_t)HALF * ldbB;
    const unsigned ldsw = (unsigned)wid * 1024u;
    const int aoff = lds_byte(wr * 64 + fr, fq * 8), boff = lds_byte(wc * 32 + fr, fq * 8);
#define PG8_SA(b, h) (((b) * 2 + (h)) * HTB)
#define PG8_SB(b, h) ((4 + (b) * 2 + (h)) * HTB)
#define PG8_STAGE(bufoff, gbase, voff) do { _Pragma("unroll") for (int _i = 0; _i < 2; ++_i) \
        __builtin_amdgcn_global_load_lds((const unsigned*)((const char*)(gbase) + (voff)[_i]), (LAS unsigned*)(lds + (bufoff) + ldsw + _i * 8192), 16, 0, 0); } while (0)
#define PG8_LD16(off) (*(const LAS v4i_t*)(lds + (off)))
#define PG8_LDA(dst, b, h) do { if constexpr (FP8) { _Pragma("unroll") for (int m = 0; m < 4; ++m) { const v4i_t x_ = PG8_LD16(PG8_SA(b, h) + aoff + m * 2048), y_ = PG8_LD16(PG8_SA(b, h) + aoff + m * 2048 + 1024); \
            dst##8[m][0] = x_.x; dst##8[m][1] = x_.y; dst##8[m][2] = x_.z; dst##8[m][3] = x_.w; dst##8[m][4] = y_.x; dst##8[m][5] = y_.y; dst##8[m][6] = y_.z; dst##8[m][7] = y_.w; } } \
        else { _Pragma("unroll") for (int m = 0; m < 4; ++m) _Pragma("unroll") for (int k = 0; k < 2; ++k) dst[m][k] = *(const LAS bf16x8*)(lds + PG8_SA(b, h) + aoff + m * 2048 + k * 1024); } } while (0)
#define PG8_LDB(dst, b, h) do { if constexpr (FP8) { _Pragma("unroll") for (int n = 0; n < 2; ++n) { const v4i_t x_ = PG8_LD16(PG8_SB(b, h) + boff + n * 2048), y_ = PG8_LD16(PG8_SB(b, h) + boff + n * 2048 + 1024); \
            dst##8[n][0] = x_.x; dst##8[n][1] = x_.y; dst##8[n][2] = x_.z; dst##8[n][3] = x_.w; dst##8[n][4] = y_.x; dst##8[n][5] = y_.y; dst##8[n][6] = y_.z; dst##8[n][7] = y_.w; } } \
        else { _Pragma("unroll") for (int n = 0; n < 2; ++n) _Pragma("unroll") for (int k = 0; k < 2; ++k) dst[n][k] = *(const LAS bf16x8*)(lds + PG8_SB(b, h) + boff + n * 2048 + k * 1024); } } while (0)
#define PG8_MMA(ai, bj, At, Bt) do { __builtin_amdgcn_s_setprio(1); if constexpr (FP8) { _Pragma("unroll") for (int m = 0; m < 4; ++m) _Pragma("unroll") for (int n = 0; n < 2; ++n) \
        asm volatile("v_mfma_scale_f32_16x16x128_f8f6f4 %0, %1, %2, %0, %3, %4 op_sel_hi:[0,0,0]" : "+v"(acc[ai][bj][m][n]) : "v"(Bt##8[n]), "v"(At##8[m]), "v"(wsc_), "v"(asc_)); } \
      else { _Pragma("unroll") for (int m = 0; m < 4; ++m) _Pragma("unroll") for (int n = 0; n < 2; ++n) _Pragma("unroll") for (int k = 0; k < 2; ++k) \
        acc[ai][bj][m][n] = __builtin_amdgcn_mfma_f32_16x16x32_bf16(Bt[n][k], At[m][k], acc[ai][bj][m][n], 0, 0, 0); } __builtin_amdgcn_s_setprio(0); } while (0)
#define PG8_WAIT_V(n) asm volatile("s_waitcnt vmcnt(" #n ")" ::: "memory")
#define PG8_WAIT_L(n) asm volatile("s_waitcnt lgkmcnt(" #n ")" ::: "memory")
#define PG8_BAR __builtin_amdgcn_s_barrier()
#define PG8_SCHED __builtin_amdgcn_sched_barrier(0)
    Unit cur, nxt; int ui = 0;
    if (!S.next(0, cur)) return;
    f32x4 acc[2][2][4][2];
#pragma unroll
    for (int a = 0; a < 2; ++a)
#pragma unroll
        for (int b = 0; b < 2; ++b)
#pragma unroll
            for (int m = 0; m < 4; ++m)
#pragma unroll
                for (int n = 0; n < 2; ++n) acc[a][b][m][n] = (f32x4){0.f, 0.f, 0.f, 0.f};
    bf16x8 At[4][2], B0[2][2], B1[2][2]; v8i_t At8[4], B08[2], B18[2]; int wsc_ = WSC, asc_ = ASC; (void)wsc_; (void)asc_;
    const char* cA = cur.a; const char* cB = cur.b;
    PG8_STAGE(PG8_SB(0, 0), cB, voffB); PG8_STAGE(PG8_SB(0, 1), cB + hstepB, voffB); PG8_STAGE(PG8_SA(0, 0), cA, voffA); PG8_STAGE(PG8_SA(0, 1), cA + hstepA, voffA);
    if (wr == 1) PG8_BAR;
    PG8_WAIT_V(2); PG8_BAR;
    PG8_STAGE(PG8_SB(1, 0), cB + kstep, voffB); PG8_STAGE(PG8_SA(1, 0), cA + kstep, voffA); PG8_STAGE(PG8_SB(1, 1), cB + hstepB + kstep, voffB);
    PG8_WAIT_V(6); PG8_BAR;
#pragma unroll 1
    for (;;) {
        const bool has_next = S.next(ui + 1, nxt);
        const char* nA = has_next ? nxt.a : cA; const char* nB = has_next ? nxt.b : cB;
#pragma unroll 1
        for (int t = 0; t < nt; t += 2) {
            const bool last = (t == nt - 2);
            const char* a1 = cA + (size_t)(t + 1) * kstep;
            const char* a2 = last ? nA : cA + (size_t)(t + 2) * kstep; const char* b2 = last ? nB : cB + (size_t)(t + 2) * kstep;
            const char* a3 = a2 + kstep; const char* b3 = b2 + kstep;
            PG8_LDB(B0, 0, 0); PG8_LDB(B1, 0, 1); PG8_SCHED; PG8_LDA(At, 0, 0); PG8_STAGE(PG8_SA(1, 1), a1 + hstepA, voffA);
            PG8_WAIT_V(8); PG8_WAIT_L(0); PG8_BAR; PG8_MMA(0, 0, At, B0); PG8_MMA(0, 1, At, B1); PG8_BAR; PG8_SCHED;
            PG8_LDA(At, 0, 1); PG8_STAGE(PG8_SB(0, 0), b2, voffB); PG8_STAGE(PG8_SB(0, 1), b2 + hstepB, voffB); PG8_STAGE(PG8_SA(0, 0), a2, voffA);
            PG8_WAIT_V(8); PG8_WAIT_L(0); PG8_BAR; PG8_MMA(1, 0, At, B0); PG8_MMA(1, 1, At, B1); PG8_BAR; PG8_SCHED;
            PG8_LDB(B0, 1, 0); PG8_LDB(B1, 1, 1); PG8_SCHED; PG8_LDA(At, 1, 0); PG8_STAGE(PG8_SA(0, 1), a2 + hstepA, voffA);
            PG8_WAIT_V(8); PG8_WAIT_L(0); PG8_BAR; PG8_MMA(0, 0, At, B0); PG8_MMA(0, 1, At, B1); PG8_BAR; PG8_SCHED;
            PG8_LDA(At, 1, 1); PG8_STAGE(PG8_SB(1, 0), b3, voffB); PG8_STAGE(PG8_SB(1, 1), b3 + hstepB, voffB); PG8_STAGE(PG8_SA(1, 0), a3, voffA);
            PG8_WAIT_V(8); PG8_WAIT_L(0); PG8_BAR; PG8_MMA(1, 0, At, B0); PG8_MMA(1, 1, At, B1); PG8_BAR; PG8_SCHED;
        }
        if (wr == 0) PG8_BAR;
        if constexpr (FP8) asm volatile("s_nop 15\n\ts_nop 15" ::: "memory");
        E(acc, cur, wr, wc, fr, fq);
        if (!has_next) break;
#pragma unroll
        for (int a = 0; a < 2; ++a)
#pragma unroll
            for (int b = 0; b < 2; ++b)
#pragma unroll
                for (int m = 0; m < 4; ++m)
#pragma unroll
                    for (int n = 0; n < 2; ++n) acc[a][b][m][n] = (f32x4){0.f, 0.f, 0.f, 0.f};
        cur = nxt; cA = nA; cB = nB; ++ui;
        if (wr == 1) PG8_BAR;
    }
    PG8_WAIT_V(0);
    PG8_BAR;
#undef PG8_SA
#undef PG8_SB
#undef PG8_STAGE
#undef PG8_LDA
#undef PG8_LD16
#undef PG8_LDB
#undef PG8_MMA
#undef PG8_WAIT_V
#undef PG8_WAIT_L
#undef PG8_BAR
#undef PG8_SCHED
}
template <class Epi, class Sched>
__device__ __forceinline__ void gemm_phase(LAS unsigned char* lds, const int K, const int lda, const int ldb, const Sched& S, const Epi& E) {
    gemm_phase_t<false, 0, 0>(lds, K / BK, lda * 2, ldb * 2, S, E);
}

template <int ACT> struct EpiBf16 {
    static constexpr bool PERM = true;
    bf16_t* O0; bf16_t* O1; bf16_t* O2; int ld0, ld12; int q8;
    __device__ __forceinline__ void operator()(const f32x4 (&acc)[2][2][4][2], const Unit& u, int wr, int wc, int fr, int fq) const {
        bf16_t* base = u.sel == 0 ? O0 : (u.sel == 1 ? O1 : O2); const int ldc = u.sel == 0 ? ld0 : ld12;
        const bool f8 = q8 && u.sel == 0;
        const int row0 = u.orow + wr * 64 + fr, col0 = u.ocol + wc * 32 + 8 * fq;
#pragma unroll
        for (int ai = 0; ai < 2; ++ai)
#pragma unroll
            for (int m = 0; m < 4; ++m) { bf16_t* rowp = base + (size_t)(row0 + ai * HALF + m * 16) * ldc + col0;
#pragma unroll
                for (int bj = 0; bj < 2; ++bj) { f32x4 v0 = acc[ai][bj][m][0], v1 = acc[ai][bj][m][1];
                    if (ACT == 1) {
#pragma unroll
                        for (int e = 0; e < 4; ++e) { float a = fmaxf(v0[e], 0.f), b = fmaxf(v1[e], 0.f); v0[e] = a * a; v1[e] = b * b; } }
                    u32x4 w; w.x = cvt_pk_bf16(v0[0], v0[1]); w.y = cvt_pk_bf16(v0[2], v0[3]); w.z = cvt_pk_bf16(v1[0], v1[1]); w.w = cvt_pk_bf16(v1[2], v1[3]);
                    if (f8) { u32x2 w8; w8.x = pk4_fp8g(v0[0], v0[1], v0[2], v0[3]); w8.y = pk4_fp8g(v1[0], v1[1], v1[2], v1[3]);
                        *(u32x2*)((unsigned char*)O0 + (size_t)(row0 + ai * HALF + m * 16) * ld0 + col0 + bj * HALF) = w8; }
                    else *(u32x4*)(rowp + bj * HALF) = w; } }
    }
};
template <bool BF> struct EpiResid {
    static constexpr bool PERM = true;
    const float* basef; bf16_t* xb; const float* gate;
    __device__ __forceinline__ void operator()(const f32x4 (&acc)[2][2][4][2], const Unit& u, int wr, int wc, int fr, int fq) const {
        const int col0 = u.ocol + wc * 32 + 8 * fq; const float* gp = gate + (size_t)(u.orow / SEQ) * NMOD + col0;
        f32x4 gv[2][2];
#pragma unroll
        for (int bj = 0; bj < 2; ++bj)
#pragma unroll
            for (int n = 0; n < 2; ++n) gv[bj][n] = *(const f32x4*)(gp + bj * HALF + 4 * n);
        if constexpr (BF) {
            u32x4 w[2][4][2];
#pragma unroll
            for (int ai = 0; ai < 2; ++ai)
#pragma unroll
                for (int m = 0; m < 4; ++m)
#pragma unroll
                    for (int bj = 0; bj < 2; ++bj) w[ai][m][bj] = *(const u32x4*)(xb + (size_t)(u.orow + ai * HALF + wr * 64 + m * 16 + fr) * DM + col0 + bj * HALF);
            asm volatile("" ::: "memory");
#pragma unroll
            for (int ai = 0; ai < 2; ++ai)
#pragma unroll
                for (int m = 0; m < 4; ++m)
#pragma unroll
                    for (int bj = 0; bj < 2; ++bj) { const u32x4 x = w[ai][m][bj];
                        const f32x4 o0 = (f32x4){bf_lo(x.x), bf_hi(x.x), bf_lo(x.y), bf_hi(x.y)} + gv[bj][0] * acc[ai][bj][m][0], o1 = (f32x4){bf_lo(x.z), bf_hi(x.z), bf_lo(x.w), bf_hi(x.w)} + gv[bj][1] * acc[ai][bj][m][1];
                        u32x4 y; y.x = cvt_pk_bf16(o0[0], o0[1]); y.y = cvt_pk_bf16(o0[2], o0[3]); y.z = cvt_pk_bf16(o1[0], o1[1]); y.w = cvt_pk_bf16(o1[2], o1[3]);
                        *(u32x4*)(xb + (size_t)(u.orow + ai * HALF + wr * 64 + m * 16 + fr) * DM + col0 + bj * HALF) = y; }
        }
#pragma unroll
        for (int ai = 0; ai < 2; ++ai) {
            if constexpr (BF) {
            } else {
#pragma unroll
                for (int mh = 0; mh < 2; ++mh) {
                    f32x4 b[2][2][2];
#pragma unroll
                    for (int mm = 0; mm < 2; ++mm)
#pragma unroll
                        for (int bj = 0; bj < 2; ++bj) { const float* bp = basef + (size_t)(u.orow + ai * HALF + wr * 64 + (2 * mh + mm) * 16 + fr) * DM + col0 + bj * HALF; b[mm][bj][0] = *(const f32x4*)bp; b[mm][bj][1] = *(const f32x4*)(bp + 4); }
                    asm volatile("" ::: "memory");
#pragma unroll
                    for (int mm = 0; mm < 2; ++mm)
#pragma unroll
                        for (int bj = 0; bj < 2; ++bj) { const int m = 2 * mh + mm; const f32x4 o0 = b[mm][bj][0] + gv[bj][0] * acc[ai][bj][m][0], o1 = b[mm][bj][1] + gv[bj][1] * acc[ai][bj][m][1];
                            u32x4 y; y.x = cvt_pk_bf16(o0[0], o0[1]); y.y = cvt_pk_bf16(o0[2], o0[3]); y.z = cvt_pk_bf16(o1[0], o1[1]); y.w = cvt_pk_bf16(o1[2], o1[3]);
                            *(u32x4*)(xb + (size_t)(u.orow + ai * HALF + wr * 64 + m * 16 + fr) * DM + col0 + bj * HALF) = y; }
                }
            }
        }
    }
};
struct EpiSeq2 {
    static constexpr bool PERM = true;
    bf16_t* Y; bf16_t* Pt; const float* zfix;
    __device__ __forceinline__ void operator()(const f32x4 (&acc)[2][2][4][2], const Unit& u, int wr, int wc, int fr, int fq) const {
        const int row0 = wr * 64 + fr, col0 = u.ocol + wc * 32 + 8 * fq;
        if (u.sel == 0) {
#pragma unroll
            for (int ai = 0; ai < 2; ++ai)
#pragma unroll
                for (int m = 0; m < 4; ++m) { bf16_t* rp = Pt + (size_t)(u.orow + row0 + ai * HALF + m * 16) * DM + col0;
#pragma unroll
                    for (int bj = 0; bj < 2; ++bj) { const f32x4 v0 = acc[ai][bj][m][0], v1 = acc[ai][bj][m][1];
                        u32x4 w; w.x = cvt_pk_bf16(v0[0], v0[1]); w.y = cvt_pk_bf16(v0[2], v0[3]); w.z = cvt_pk_bf16(v1[0], v1[1]); w.w = cvt_pk_bf16(v1[2], v1[3]);
                        *(u32x4*)(rp + bj * HALF) = w; } }
        } else {
            const int b = u.aux >> 16, k0 = u.aux & 0xffff;
            const float sg = (fr & 1) ? -(1.f / 64.f) : (1.f / 64.f);
            const float* zp = zfix + b * DM + col0;
            f32x4 z[2][2];
#pragma unroll
            for (int bj = 0; bj < 2; ++bj)
#pragma unroll
                for (int n = 0; n < 2; ++n) z[bj][n] = *(const f32x4*)(zp + bj * HALF + 4 * n) * sg;
#pragma unroll
            for (int ai = 0; ai < 2; ++ai) {
                u32x4 pw[4][2];
#pragma unroll
                for (int m = 0; m < 4; ++m)
#pragma unroll
                    for (int bj = 0; bj < 2; ++bj) pw[m][bj] = *(const u32x4*)(Pt + (size_t)(u.orow + row0 + ai * HALF + m * 16) * DM + col0 + bj * HALF);
                asm volatile("" ::: "memory");
#pragma unroll
                for (int m = 0; m < 4; ++m) { const int r = row0 + ai * HALF + m * 16, k = k0 + r;
                    bf16_t* y1 = Y + ((size_t)b * SEQ + k) * DM + col0; bf16_t* y2 = Y + ((size_t)b * SEQ + (SEQ - k)) * DM + col0;
#pragma unroll
                    for (int bj = 0; bj < 2; ++bj) { const u32x4 x = pw[m][bj];
                        const f32x4 p0 = (f32x4){bf_lo(x.x), bf_hi(x.x), bf_lo(x.y), bf_hi(x.y)} + z[bj][0], p1 = (f32x4){bf_lo(x.z), bf_hi(x.z), bf_lo(x.w), bf_hi(x.w)} + z[bj][1];
                        const f32x4 q0 = acc[ai][bj][m][0], q1 = acc[ai][bj][m][1];
                        { const f32x4 v0 = p0 - q0, v1 = p1 - q1; u32x4 w; w.x = cvt_pk_bf16(v0[0], v0[1]); w.y = cvt_pk_bf16(v0[2], v0[3]); w.z = cvt_pk_bf16(v1[0], v1[1]); w.w = cvt_pk_bf16(v1[2], v1[3]); *(u32x4*)(y1 + bj * HALF) = w; }
                        if (k > 0) { const f32x4 v0 = p0 + q0, v1 = p1 + q1; u32x4 w; w.x = cvt_pk_bf16(v0[0], v0[1]); w.y = cvt_pk_bf16(v0[2], v0[3]); w.z = cvt_pk_bf16(v1[0], v1[1]); w.w = cvt_pk_bf16(v1[2], v1[3]); *(u32x4*)(y2 + bj * HALF) = w; } } }
            }
        }
    }
};

struct SchedStd {
    const char* A; const char* B; int nM, nN, G, c; size_t astep, bstep; int wgm;
    __device__ __forceinline__ bool next(int i, Unit& u) const {
        const int L = i * G + c; if (L >= nM * nN) return false;
        int pm, pn; tile_map(L, nM, nN, pm, pn, wgm ? wgm : 8);
        u.a = A + (size_t)pm * astep; u.b = B + (size_t)pn * bstep; u.orow = pm * BM; u.ocol = pn * BM; u.sel = 0; return true;
    }
};
struct SchedQKV {
    const char* A; const char* B; int G, c;
    __device__ __forceinline__ bool next(int i, Unit& u) const {
        const int L = i * G + c; if (L >= 784) return false;
        int pm, pn; if (L < 768) tile_map(L, 64, 12, pm, pn); else { pm = 64 + (L - 768) / 4; pn = 8 + (L - 768) % 4; }
        u.a = A + (size_t)pm * (BM * DM); u.b = B + (size_t)pn * (BM * DM);
        if (pn < 8) { u.sel = 0; u.orow = pm * BM; u.ocol = pn * BM; }
        else { const int krow = pm < 64 ? pm * BM + CTXL * (pm / 16) : (pm - 64) * SKV + SEQ;
               u.orow = krow; if (pn < 10) { u.sel = 1; u.ocol = (pn - 8) * BM; } else { u.sel = 2; u.ocol = (pn - 10) * BM; } }
        return true;
    }
};
struct SchedChan {
    const char* C; const char* Sm; const char* U; int G, c;
    __device__ __forceinline__ bool next(int i, Unit& u) const {
        const int L = i * G + c; if (L >= 512) return false;
        const int g = L & 7, b = (L >> 3) & 3, jt = L >> 5;
        u.a = jt < 8 ? C : Sm; u.b = U + ((size_t)(b * SEQ + jt * BM) * DM + g * 256) * 2;
        u.orow = (b * 8 + g) * BM; u.ocol = jt * BM; u.sel = 0; return true;
    }
};
struct SchedSeq2 {
    const char* T; const char* ZT; int G, c;
    __device__ __forceinline__ bool next(int i, Unit& u) const {
        const int tile = (i >> 1) * G + c, kind = i & 1; if (tile >= 256) return false;
        int pm, pn; tile_map(tile, 8, 32, pm, pn);
        u.a = T + (size_t)kind * (8u << 20) + (size_t)pm * (BM * 2048 * 2); u.b = ZT + (size_t)pn * (BM * 4096 * 2) + (size_t)kind * (2048 * 2);
        u.orow = (pn >> 3) * 2048 + pm * BM; u.ocol = (pn & 7) * BM; u.sel = kind; u.aux = ((pn >> 3) << 16) | (pm * BM); return true;
    }
};
}

namespace att {
constexpr int D = 128, NW = 8, QBLK = 32, KVBLK = 64;
constexpr float SCALE = 0.088388347648318440f;
constexpr float THR = 8.f;
constexpr int LDQ = DM, LDK = KVD, LDO = DM;
constexpr size_t SHM_V = KVBLK * D * 2, SHM_K = KVBLK * D * 2, SHM_ATTN = 2 * SHM_V + 2 * SHM_K + NW * 64 * 4;
#define KSWZ(row, colB) ((row) * 256 + ((colB) ^ (((row) & 7) << 4)))
#define SBAR() __builtin_amdgcn_sched_barrier(0)
__device__ __forceinline__ int crow(int r, int hi) { return (r & 3) + 8 * (r >> 2) + 4 * hi; }
__device__ __forceinline__ unsigned cvtpk(float lo, float hi) { unsigned r; asm volatile("v_cvt_pk_bf16_f32 %0, %1, %2" : "=v"(r) : "v"(lo), "v"(hi)); return r; }

__device__ __forceinline__ void partialSM(f32x16& p0, f32x16& p1, float& m_reg, float& mn, float& alpha) {
  constexpr float C = SCALE * 1.4426950408889634f;
  float pmax = p0[0]; for (int r = 1; r < 16; ++r) pmax = fmaxf(pmax, p0[r]); for (int r = 0; r < 16; ++r) pmax = fmaxf(pmax, p1[r]);
  { auto rr = __builtin_amdgcn_permlane32_swap(__float_as_uint(pmax), __float_as_uint(pmax), false, false);
    pmax = fmaxf(__uint_as_float(rr[0]), __uint_as_float(rr[1])); }
  if (__builtin_expect(__all(pmax - m_reg <= THR / SCALE), 1)) { mn = m_reg; alpha = 1.f; }
  else { mn = fmaxf(m_reg, pmax); alpha = __builtin_amdgcn_exp2f((m_reg - mn) * C); m_reg = mn; }
  float mnC = -mn * C;
  for (int r = 0; r < 16; ++r) p0[r] = fmaf(p0[r], C, mnC); for (int r = 0; r < 16; ++r) p1[r] = fmaf(p1[r], C, mnC);
  for (int r = 0; r < 16; ++r) p0[r] = __builtin_amdgcn_exp2f(p0[r]);
}
__device__ __forceinline__ void finishSM(f32x16& p0, f32x16& p1, float alpha, float& l_reg, bf16x8& pa0, bf16x8& pa1, bf16x8& pa2, bf16x8& pa3) {
  for (int r = 0; r < 16; ++r) p1[r] = __builtin_amdgcn_exp2f(p1[r]);
  float ps = 0; for (int r = 0; r < 16; ++r) ps += p0[r]; for (int r = 0; r < 16; ++r) ps += p1[r];
  { auto rr = __builtin_amdgcn_permlane32_swap(__float_as_uint(ps), __float_as_uint(ps), false, false);
    ps = __uint_as_float(rr[0]) + __uint_as_float(rr[1]); }
  l_reg = l_reg * alpha + ps;
#define PK4(P, BASE, OUT) do { unsigned a0 = cvtpk(P[BASE + 0], P[BASE + 1]), a1 = cvtpk(P[BASE + 2], P[BASE + 3]);   \
    unsigned b0 = cvtpk(P[BASE + 4], P[BASE + 5]), b1 = cvtpk(P[BASE + 6], P[BASE + 7]);                              \
    auto r0 = __builtin_amdgcn_permlane32_swap(a0, b0, false, false); auto r1 = __builtin_amdgcn_permlane32_swap(a1, b1, false, false); \
    u32x4 w = {r0[0], r1[0], r0[1], r1[1]}; OUT = *reinterpret_cast<bf16x8*>(&w); } while (0)
  PK4(p0, 0, pa0); PK4(p0, 8, pa1); PK4(p1, 0, pa2); PK4(p1, 8, pa3);
#undef PK4
}
__device__ __forceinline__ void qkt(f32x16& p0, f32x16& p1, const bf16_t* Ks, const bf16x8* qr, int r32, int hi) {
  p0 = f32x16{}; p1 = f32x16{};
  for (int d0 = 0; d0 < 8; ++d0) { int cb = (d0 * 16 + hi * 8) * 2;
    bf16x8 b0 = *reinterpret_cast<const bf16x8*>((const char*)Ks + KSWZ(r32, cb));
    bf16x8 b1 = *reinterpret_cast<const bf16x8*>((const char*)Ks + KSWZ(32 + r32, cb));
    p0 = __builtin_amdgcn_mfma_f32_32x32x16_bf16(b0, qr[d0], p0, 0, 0, 0);
    p1 = __builtin_amdgcn_mfma_f32_32x32x16_bf16(b1, qr[d0], p1, 0, 0, 0); }
}
__device__ __forceinline__ int v_st(int k, int c) { const int kk = (k & ~0xC) | ((k & 4) << 1) | ((k & 8) >> 1); return ((kk >> 3) * 4 + (c >> 5)) * 512 + ((kk & 7) * 32 + (c & 31)) * 2; }
__device__ __forceinline__ int v_rd_base(int lane) { return ((lane & 3) << 3) | (((lane >> 2) & 3) << 6) | (((lane >> 4) & 1) << 5) | (((lane >> 5) & 1) << 8); }
constexpr int v_rd_off(int d0, int ks, int half) { return d0 * 512 + ks * 4096 + half * 2048; }
template <int OFF> __device__ __forceinline__ s16x4 tr_read(int vb) {
  s16x4 r; asm volatile("ds_read_b64_tr_b16 %0, %1 offset:%2" : "=&v"(r) : "v"(vb), "i"(OFF) : "memory"); return r;
}
template <int D0> __device__ __forceinline__ void pv_one(f32x16& od, int vb, bf16x8 pa0, bf16x8 pa1, bf16x8 pa2, bf16x8 pa3) {
  const s16x4 l0 = tr_read<v_rd_off(D0, 0, 0)>(vb), h0 = tr_read<v_rd_off(D0, 0, 1)>(vb), l1 = tr_read<v_rd_off(D0, 1, 0)>(vb), h1 = tr_read<v_rd_off(D0, 1, 1)>(vb);
  const s16x4 l2 = tr_read<v_rd_off(D0, 2, 0)>(vb), h2 = tr_read<v_rd_off(D0, 2, 1)>(vb), l3 = tr_read<v_rd_off(D0, 3, 0)>(vb), h3 = tr_read<v_rd_off(D0, 3, 1)>(vb);
  asm volatile("s_waitcnt lgkmcnt(0)" ::: "memory"); SBAR();
#define PK(L, H) (bf16x8){L[0], L[1], L[2], L[3], H[0], H[1], H[2], H[3]}
  od = __builtin_amdgcn_mfma_f32_32x32x16_bf16(pa0, PK(l0, h0), od, 0, 0, 0);
  od = __builtin_amdgcn_mfma_f32_32x32x16_bf16(pa1, PK(l1, h1), od, 0, 0, 0);
  od = __builtin_amdgcn_mfma_f32_32x32x16_bf16(pa2, PK(l2, h2), od, 0, 0, 0);
  od = __builtin_amdgcn_mfma_f32_32x32x16_bf16(pa3, PK(l3, h3), od, 0, 0, 0);
#undef PK
}
__device__ __forceinline__ void pv_d0(f32x16* o, int vb, bf16x8 pa0, bf16x8 pa1, bf16x8 pa2, bf16x8 pa3) {
  pv_one<0>(o[0], vb, pa0, pa1, pa2, pa3); pv_one<1>(o[1], vb, pa0, pa1, pa2, pa3); pv_one<2>(o[2], vb, pa0, pa1, pa2, pa3); pv_one<3>(o[3], vb, pa0, pa1, pa2, pa3);
}

__device__ __forceinline__ void attn_dense_body(const bf16_t* __restrict__ Qb, const bf16_t* __restrict__ Kh, const bf16_t* __restrict__ Vh,
                                                bf16_t* __restrict__ Ob, int seq, int s0, const float* __restrict__ qg,
                                                const float* __restrict__ ropec, const float* __restrict__ ropes, char* lds) {
  int tid_o = threadIdx.x; asm volatile("" : "+v"(tid_o));
  const int tid = tid_o, wid = tid >> 6, lane = tid & 63, r32 = lane & 31, hi = lane >> 5;
  bf16_t* V_lds = (bf16_t*)lds; bf16_t* K_lds = (bf16_t*)(lds + 2 * SHM_V);
  float* ws = (float*)(lds + 2 * SHM_V + 2 * SHM_K) + wid * 64; float* li_l = ws; float* al_l = ws + 32;
  float m_reg = -1e30f, l_reg = 0; f32x16 o[4] = {}; bf16x8 qr[8];
  {
    const bf16_t* Qw = Qb + (long)(wid * QBLK + r32) * LDQ + hi * 8;
    u32x4 raw[8];
#pragma unroll
    for (int d0 = 0; d0 < 8; ++d0) raw[d0] = *reinterpret_cast<const u32x4*>(Qw + d0 * 16);
    float ss = 0.f;
#pragma unroll
    for (int d0 = 0; d0 < 8; ++d0)
#pragma unroll
      for (int e = 0; e < 4; ++e) { const float a = bf_lo(raw[d0][e]), b = bf_hi(raw[d0][e]); ss += a * a + b * b; }
    { auto rr = __builtin_amdgcn_permlane32_swap(__float_as_uint(ss), __float_as_uint(ss), false, false); ss = __uint_as_float(rr[0]) + __uint_as_float(rr[1]); }
    const float rstd = 1.0f / sqrtf(ss * (1.f / 128.f) + EPS);
    const int s = s0 + wid * QBLK + r32, prow = s >> 6, pcol = s & 63;
#pragma unroll
    for (int d0 = 0; d0 < 8; ++d0) {
      const int pos = d0 < 4 ? prow : pcol, f0 = (8 * d0 + 4 * hi) & 31;
      const f32x4 c4 = *reinterpret_cast<const f32x4*>(ropec + pos * 32 + f0), s4 = *reinterpret_cast<const f32x4*>(ropes + pos * 32 + f0);
      const f32x4 g0 = *reinterpret_cast<const f32x4*>(qg + d0 * 16 + hi * 8), g1 = *reinterpret_cast<const f32x4*>(qg + d0 * 16 + hi * 8 + 4);
      u32x4 w;
#pragma unroll
      for (int e = 0; e < 4; ++e) { const float gl = e < 2 ? g0[2 * e] : g1[2 * e - 4], gh = e < 2 ? g0[2 * e + 1] : g1[2 * e - 3];
        const float y0 = bf_lo(raw[d0][e]) * rstd * gl, y1 = bf_hi(raw[d0][e]) * rstd * gh;
        w[e] = cvtpk(y0 * c4[e] - y1 * s4[e], y0 * s4[e] + y1 * c4[e]); }
      qr[d0] = *reinterpret_cast<bf16x8*>(&w);
    }
  }
  const int sr = tid >> 4, sc = (tid & 15) * 8, vst0 = v_st(sr, sc), vst1 = v_st(32 + sr, sc);
  const int vb0 = (int)(uintptr_t)V_lds + v_rd_base(lane);
  struct { bf16x8 vs0, vs1, ks0, ks1; } sr_[2];
#define LD8(p) (*reinterpret_cast<const bf16x8*>(p))
#define SLOAD(i, k0) do { sr_[i].vs0 = LD8(&Vh[(long)((k0) + sr) * LDK + sc]); sr_[i].vs1 = LD8(&Vh[(long)((k0) + 32 + sr) * LDK + sc]); \
    sr_[i].ks0 = LD8(&Kh[(long)((k0) + sr) * LDK + sc]); sr_[i].ks1 = LD8(&Kh[(long)((k0) + 32 + sr) * LDK + sc]); } while (0)
#define SWRITE(b, i) do { *(bf16x8*)((char*)V_lds + (b) * SHM_V + vst0) = sr_[i].vs0;          \
    *(bf16x8*)((char*)V_lds + (b) * SHM_V + vst1) = sr_[i].vs1; int kc = sc * 2;               \
    *(bf16x8*)((char*)K_lds + (b) * SHM_K + KSWZ(sr, kc)) = sr_[i].ks0;                       \
    *(bf16x8*)((char*)K_lds + (b) * SHM_K + KSWZ(32 + sr, kc)) = sr_[i].ks1; } while (0)
#define SWAIT() asm volatile("s_waitcnt vmcnt(4)" ::: "memory")
#define RESC(a) do { if (__any((a) < 1.f)) { if (hi == 0) al_l[r32] = (a); asm volatile("s_waitcnt lgkmcnt(0)" ::: "memory"); \
    for (int d = 0; d < 4; ++d) for (int r = 0; r < 16; ++r) o[d][r] *= al_l[crow(r, hi)]; } } while (0)
  f32x16 pA0, pA1, pB0, pB1; float mnA, mnB, alA, alB; bf16x8 pa0, pa1, pa2, pa3; const int NT = seq / KVBLK;
  constexpr int SE = 0, SO = 1;
  SLOAD(SE, 0); asm volatile("s_waitcnt vmcnt(0)" ::: "memory"); SWRITE(0, SE); __syncthreads();
  qkt(pA0, pA1, K_lds, qr, r32, hi); partialSM(pA0, pA1, m_reg, mnA, alA);
  SLOAD(SO, KVBLK); if (2 < NT) SLOAD(SE, 2 * KVBLK);
  SWAIT(); SWRITE(1, SO); __syncthreads();
  for (int j = 1; j + 1 < NT; j += 2) {
    SBAR(); qkt(pB0, pB1, (bf16_t*)((char*)K_lds + SHM_K), qr, r32, hi);
    finishSM(pA0, pA1, alA, l_reg, pa0, pa1, pa2, pa3); SBAR();
    SLOAD(SO, (j + 2) * KVBLK); SBAR();
    pv_d0(o, vb0, pa0, pa1, pa2, pa3); partialSM(pB0, pB1, m_reg, mnB, alB);
    __syncthreads(); SWAIT(); SWRITE(0, SE);
    RESC(alB); __syncthreads();
    SBAR(); qkt(pA0, pA1, K_lds, qr, r32, hi);
    finishSM(pB0, pB1, alB, l_reg, pa0, pa1, pa2, pa3); SBAR();
    if (j + 3 < NT) SLOAD(SE, (j + 3) * KVBLK); SBAR();
    pv_d0(o, vb0 + (int)SHM_V, pa0, pa1, pa2, pa3); partialSM(pA0, pA1, m_reg, mnA, alA);
    __syncthreads(); SWAIT(); SWRITE(1, SO);
    RESC(alA); __syncthreads();
  }
  SBAR(); qkt(pB0, pB1, (bf16_t*)((char*)K_lds + SHM_K), qr, r32, hi);
  finishSM(pA0, pA1, alA, l_reg, pa0, pa1, pa2, pa3); SBAR();
  pv_d0(o, vb0, pa0, pa1, pa2, pa3); partialSM(pB0, pB1, m_reg, mnB, alB);
  __syncthreads(); RESC(alB);
  finishSM(pB0, pB1, alB, l_reg, pa0, pa1, pa2, pa3); SBAR();
  pv_d0(o, vb0 + (int)SHM_V, pa0, pa1, pa2, pa3);
  if (hi == 0) li_l[r32] = l_reg; asm volatile("s_waitcnt lgkmcnt(0)" ::: "memory");
  float rli[16];
#pragma unroll
  for (int r = 0; r < 16; ++r) rli[r] = __builtin_amdgcn_rcpf(li_l[crow(r, hi)]);
  bf16_t* Ow = Ob + (long)(wid * QBLK) * LDO;
#pragma unroll
  for (int r = 0; r < 16; ++r) { int orow = crow(r, hi);
    for (int d0 = 0; d0 < 4; ++d0) Ow[(long)orow * LDO + d0 * 32 + r32] = (bf16_t)f2bf(o[d0][r] * rli[r]); }
  __syncthreads();
#undef LD8
#undef SLOAD
#undef SWRITE
#undef SWAIT
#undef RESC
}
#undef KSWZ
#undef SBAR
}


namespace att8 {
typedef int v8i __attribute__((ext_vector_type(8)));
constexpr int NW = 8, QBLK = 32, KVBLK = 64, TILEB = 8192;
constexpr float SCALE = 0.088388347648318440f;
constexpr float THR = 3.5f;
constexpr float PBIAS = 3.0f;
constexpr int NSLOT = 6, LDS_K = 0, LDS_V = NSLOT * TILEB, LDS_WS = 2 * NSLOT * TILEB;
#define SBAR() __builtin_amdgcn_sched_barrier(0)
__device__ __forceinline__ int crow(int r, int hi) { return (r & 3) + 8 * (r >> 2) + 4 * hi; }
__device__ __forceinline__ f32x16 mfma8(v8i a, v8i b, f32x16 c) { return __builtin_amdgcn_mfma_scale_f32_32x32x64_f8f6f4(a, b, c, 0, 0, 0, 0x7f7f7f7f, 0, 0x7f7f7f7f); }
__device__ __forceinline__ unsigned pk4_fp8(float a, float b, float c, float d) { unsigned w;
  asm("v_cvt_pk_fp8_f32 %0, %1, %2" : "=v"(w) : "v"(a), "v"(b)); asm("v_cvt_pk_fp8_f32 %0, %1, %2 op_sel:[0,0,1]" : "+v"(w) : "v"(c), "v"(d)); return w; }
__device__ __forceinline__ v8i ld32(const LAS unsigned char* p0, const LAS unsigned char* p1) {
  const u32x4 a = *(const LAS u32x4*)p0, b = *(const LAS u32x4*)p1; v8i r; r[0] = a.x; r[1] = a.y; r[2] = a.z; r[3] = a.w; r[4] = b.x; r[5] = b.y; r[6] = b.z; r[7] = b.w; return r; }

template <bool FIRST> __device__ __forceinline__ void partialSM(f32x16& p0, f32x16& p1, float& mhat, f32x16& negm, float& alpha) {
  constexpr float THRL = THR * 1.4426950408889634f;
  float pmax = p0[0]; for (int r = 1; r < 16; ++r) pmax = fmaxf(pmax, p0[r]); for (int r = 0; r < 16; ++r) pmax = fmaxf(pmax, p1[r]);
  { auto rr = __builtin_amdgcn_permlane32_swap(__float_as_uint(pmax), __float_as_uint(pmax), false, false);
    pmax = fmaxf(__uint_as_float(rr[0]), __uint_as_float(rr[1])); }
  const float rm = pmax - PBIAS;
  alpha = 1.f;
  if (FIRST || !__builtin_expect(__all(rm <= THRL), 1)) {
    const float dl = FIRST ? rm : fmaxf(rm, 0.f); mhat += dl;
    for (int r = 0; r < 16; ++r) { p0[r] -= dl; p1[r] -= dl; }
    const float nm = PBIAS - mhat; for (int r = 0; r < 16; ++r) negm[r] = nm;
    if (!FIRST) alpha = __builtin_amdgcn_exp2f(-dl);
  }
  for (int r = 0; r < 16; ++r) p0[r] = __builtin_amdgcn_exp2f(p0[r]);
}
__device__ __forceinline__ void finishSM(f32x16& p0, f32x16& p1, float alpha, float& l_reg, v8i& pa) {
  for (int r = 0; r < 16; ++r) p1[r] = __builtin_amdgcn_exp2f(p1[r]);
  float ps = 0; for (int r = 0; r < 16; ++r) ps += p0[r]; for (int r = 0; r < 16; ++r) ps += p1[r];
  { auto rr = __builtin_amdgcn_permlane32_swap(__float_as_uint(ps), __float_as_uint(ps), false, false);
    ps = __uint_as_float(rr[0]) + __uint_as_float(rr[1]); }
  l_reg = l_reg * alpha + ps;
#pragma unroll
  for (int w = 0; w < 4; ++w) { pa[w] = (int)pk4_fp8(p0[4 * w], p0[4 * w + 1], p0[4 * w + 2], p0[4 * w + 3]); pa[4 + w] = (int)pk4_fp8(p1[4 * w], p1[4 * w + 1], p1[4 * w + 2], p1[4 * w + 3]); }
}
__device__ __forceinline__ void qkt(f32x16& p0, f32x16& p1, const LAS unsigned char* Ks, const v8i* qr, const f32x16& negm, int r32, int hi) {
  const int sw = (r32 >> 1) & 7;
  const LAS unsigned char* ra = Ks + r32 * 128; const LAS unsigned char* rb = Ks + (32 + r32) * 128;
#pragma unroll
  for (int m = 0; m < 2; ++m) { const int c0 = 4 * m + 2 * hi;
    const v8i a0 = ld32(ra + 16 * (c0 ^ sw), ra + 16 * ((c0 + 1) ^ sw)), a1 = ld32(rb + 16 * (c0 ^ sw), rb + 16 * ((c0 + 1) ^ sw));
    if (m == 0) { p0 = mfma8(a0, qr[0], negm); p1 = mfma8(a1, qr[0], negm); } else { p0 = mfma8(a0, qr[1], p0); p1 = mfma8(a1, qr[1], p1); } }
}
__device__ __forceinline__ void pv(f32x16* o, const LAS unsigned char* Vs, v8i pa, int r32, int hi) {
#pragma unroll
  for (int d0 = 0; d0 < 4; ++d0) { const int d = 32 * d0 + r32, sw = (d >> 2) & 3; const LAS unsigned char* rp = Vs + d * 64;
    const v8i bf = ld32(rp + 16 * ((2 * hi) ^ sw), rp + 16 * ((2 * hi + 1) ^ sw));
    o[d0] = mfma8(pa, bf, o[d0]); }
}

__device__ __forceinline__ void attn_body(const bf16_t* __restrict__ Qb, const unsigned char* __restrict__ K8h, const unsigned char* __restrict__ V8h,
                                          bf16_t* __restrict__ Ob, int NT, int s0, const float* __restrict__ qg,
                                          const float* __restrict__ ropec, const float* __restrict__ ropes, LAS unsigned char* lds) {
  int tid_o = threadIdx.x; asm volatile("" : "+v"(tid_o));
  const int tid = tid_o, wid = tid >> 6, lane = tid & 63, r32 = lane & 31, hi = lane >> 5;
  LAS unsigned char* V_lds = lds + LDS_V; LAS unsigned char* K_lds = lds + LDS_K;
  LAS float* ws = (LAS float*)(lds + LDS_WS) + wid * 64; LAS float* li_l = ws; LAS float* al_l = ws + 32;
  float mhat = 0.f, l_reg = 0; f32x16 o[4] = {}; v8i qr[2]; f32x16 negm; { float nb = PBIAS; asm volatile("" : "+v"(nb)); for (int r = 0; r < 16; ++r) negm[r] = nb; }
  {
    const unsigned char* Qw = (const unsigned char*)Qb + (long)(wid * QBLK + r32) * DM + hi * 32;
    u32x2 raw[2][4];
#pragma unroll
    for (int m = 0; m < 2; ++m)
#pragma unroll
      for (int c = 0; c < 4; ++c) raw[m][c] = *reinterpret_cast<const u32x2*>(Qw + 64 * m + 8 * c);
    float ss = 0.f;
#pragma unroll
    for (int m = 0; m < 2; ++m)
#pragma unroll
      for (int c = 0; c < 4; ++c)
#pragma unroll
        for (int d = 0; d < 2; ++d) { const auto pl = __builtin_amdgcn_cvt_pk_f32_fp8((int)raw[m][c][d], false); const auto ph = __builtin_amdgcn_cvt_pk_f32_fp8((int)raw[m][c][d], true); ss += (pl[0] * pl[0] + pl[1] * pl[1]) + (ph[0] * ph[0] + ph[1] * ph[1]); }
    { auto rr = __builtin_amdgcn_permlane32_swap(__float_as_uint(ss), __float_as_uint(ss), false, false); ss = __uint_as_float(rr[0]) + __uint_as_float(rr[1]); }
    const float rstd = (SCALE * 1.4426950408889634f) / sqrtf(ss * (1.f / 128.f) + EPS);
    const int s = s0 + wid * QBLK + r32, prow = s >> 6, pcol = s & 63;
#pragma unroll
    for (int m = 0; m < 2; ++m) { const int pos = m == 0 ? prow : pcol;
#pragma unroll
      for (int c = 0; c < 4; ++c) { const int f0 = 16 * hi + 4 * c, dd = 64 * m + 32 * hi + 8 * c;
        const f32x4 c4 = *reinterpret_cast<const f32x4*>(ropec + pos * 32 + f0), s4 = *reinterpret_cast<const f32x4*>(ropes + pos * 32 + f0);
        const f32x4 g0 = *reinterpret_cast<const f32x4*>(qg + dd), g1 = *reinterpret_cast<const f32x4*>(qg + dd + 4);
        float ov[8];
#pragma unroll
        for (int e = 0; e < 4; ++e) { const float gl = e < 2 ? g0[2 * e] : g1[2 * e - 4], gh = e < 2 ? g0[2 * e + 1] : g1[2 * e - 3];
          const auto prl = __builtin_amdgcn_cvt_pk_f32_fp8((int)raw[m][c][e >> 1], false); const auto prh = __builtin_amdgcn_cvt_pk_f32_fp8((int)raw[m][c][e >> 1], true);
          const float y0 = ((e & 1) ? prh[0] : prl[0]) * rstd * gl, y1 = ((e & 1) ? prh[1] : prl[1]) * rstd * gh;
          ov[2 * e] = y0 * c4[e] - y1 * s4[e]; ov[2 * e + 1] = y0 * s4[e] + y1 * c4[e]; }
        qr[m][2 * c] = (int)pk4_fp8(ov[0], ov[1], ov[2], ov[3]); qr[m][2 * c + 1] = (int)pk4_fp8(ov[4], ov[5], ov[6], ov[7]); } }
  }
  struct { u32x4 k0, v0, k1, v1; } st;
#define KSLOT(t) (K_lds + ((t) % NSLOT) * TILEB)
#define VSLOT(t) (V_lds + ((t) % NSLOT) * TILEB)
#define GLD(base, t) (*reinterpret_cast<const u32x4*>((base) + (size_t)(t) * TILEB + tid * 16))
#define PLOAD(t) do { if ((t) < NT) { st.k0 = GLD(K8h, (t)); st.v0 = GLD(V8h, (t)); } if ((t) + 1 < NT) { st.k1 = GLD(K8h, (t) + 1); st.v1 = GLD(V8h, (t) + 1); } } while (0)
#define PWRITE(t) do { if ((t) < NT) { *(LAS u32x4*)(KSLOT(t) + tid * 16) = st.k0; *(LAS u32x4*)(VSLOT(t) + tid * 16) = st.v0; } \
    if ((t) + 1 < NT) { *(LAS u32x4*)(KSLOT((t) + 1) + tid * 16) = st.k1; *(LAS u32x4*)(VSLOT((t) + 1) + tid * 16) = st.v1; } } while (0)
#define VMW0() asm volatile("s_waitcnt vmcnt(0)" ::: "memory")
#define RESC(a) do { if (__any((a) < 1.f)) { if (hi == 0) al_l[r32] = (a); asm volatile("s_waitcnt lgkmcnt(0)" ::: "memory"); \
    for (int d = 0; d < 4; ++d) for (int r = 0; r < 16; ++r) o[d][r] *= al_l[crow(r, hi)]; } } while (0)
  f32x16 pA0, pA1, pB0, pB1; float alA, alB; v8i pa;
  { const u32x4 k = GLD(K8h, 0), v = GLD(V8h, 0); VMW0(); *(LAS u32x4*)(KSLOT(0) + tid * 16) = k; *(LAS u32x4*)(VSLOT(0) + tid * 16) = v; }
  PLOAD(1); VMW0(); PWRITE(1);
  PLOAD(3);
  __syncthreads();
  qkt(pA0, pA1, KSLOT(0), qr, negm, r32, hi); partialSM<true>(pA0, pA1, mhat, negm, alA);
#pragma unroll 1
  for (int j = 1; j + 1 < NT; j += 2) {
    __syncthreads();
    VMW0(); PWRITE(j + 2); PLOAD(j + 4);
    SBAR(); qkt(pB0, pB1, KSLOT(j), qr, negm, r32, hi);
    finishSM(pA0, pA1, alA, l_reg, pa); SBAR();
    pv(o, VSLOT(j - 1), pa, r32, hi); partialSM<false>(pB0, pB1, mhat, negm, alB);
    RESC(alB);
    SBAR(); qkt(pA0, pA1, KSLOT(j + 1), qr, negm, r32, hi);
    finishSM(pB0, pB1, alB, l_reg, pa); SBAR();
    pv(o, VSLOT(j), pa, r32, hi); partialSM<false>(pA0, pA1, mhat, negm, alA);
    RESC(alA);
  }
  __syncthreads();
  SBAR(); qkt(pB0, pB1, KSLOT(NT - 1), qr, negm, r32, hi);
  finishSM(pA0, pA1, alA, l_reg, pa); SBAR();
  pv(o, VSLOT(NT - 2), pa, r32, hi); partialSM<false>(pB0, pB1, mhat, negm, alB);
  RESC(alB);
  finishSM(pB0, pB1, alB, l_reg, pa); SBAR();
  pv(o, VSLOT(NT - 1), pa, r32, hi);
  if (hi == 0) li_l[r32] = l_reg; asm volatile("s_waitcnt lgkmcnt(0)" ::: "memory");
  float rli[16];
#pragma unroll
  for (int r = 0; r < 16; ++r) rli[r] = __builtin_amdgcn_rcpf(li_l[crow(r, hi)]);
  unsigned char* Ow = (unsigned char*)Ob + (long)(wid * QBLK) * DM;
#pragma unroll
  for (int r = 0; r < 16; ++r) { int orow = crow(r, hi); const float sc = rli[r] * 32.0f;
    const unsigned w = pk4_fp8(o[0][r] * sc, o[1][r] * sc, o[2][r] * sc, o[3][r] * sc);
#pragma unroll
    for (int d0 = 0; d0 < 4; ++d0) Ow[(long)orow * DM + d0 * 32 + r32] = (unsigned char)((w >> (8 * d0)) & 0xffu); }
  __syncthreads();
#undef KSLOT
#undef VSLOT
#undef GLD
#undef PLOAD
#undef PWRITE
#undef VMW0
#undef RESC
}
#undef SBAR
}

#define XB_TMO      128
#define XB_XCNT(j)  (256  + 64 * (j))
#define XB_XSUB(j)  (1280 + 64 * (j))
#define XB_XGEN(j)  (2304 + 64 * (j))
#define XB_TOP      3328
#define XB_TOPGEN   3392
#define XCD_BAR_WORDS 3456
#define XB_SPIN_CAP (1u << 18)
__device__ __forceinline__ unsigned xb_ld(unsigned* p)              { return __hip_atomic_load(p, __ATOMIC_RELAXED, __HIP_MEMORY_SCOPE_AGENT); }
__device__ __forceinline__ unsigned xb_add(unsigned* p, unsigned v) { return __hip_atomic_fetch_add(p, v, __ATOMIC_RELAXED, __HIP_MEMORY_SCOPE_AGENT); }
__device__ __forceinline__ unsigned xb_xcc_id() { return (unsigned)__builtin_amdgcn_s_getreg((3 << 11) | 20) & 0xFu; }
#define XB_SPIN(cond, bar) do { unsigned _sp = 0; while (cond) { __builtin_amdgcn_s_sleep(1); \
    if ((++_sp & 255u) == 0u) { if (xb_ld(&(bar)[XB_TMO])) break; if (_sp > XB_SPIN_CAP) { atomicAdd(&(bar)[XB_TMO], 1u); break; } } } } while (0)
struct XcdBarrier { unsigned* bar; unsigned x; volatile LAS unsigned* st; };
__device__ __forceinline__ XcdBarrier xcd_barrier_post(unsigned* bar, volatile LAS unsigned* st) {
    XcdBarrier b; b.bar = bar; b.x = xb_xcc_id(); b.st = st;
    if (threadIdx.x == 0) (void)xb_add(&bar[XB_XCNT(b.x)], 1u);
    return b;
}
__device__ __forceinline__ void xcd_barrier_complete(unsigned* bar, unsigned x, unsigned& nloc, unsigned& nx) {
    const unsigned G = gridDim.x * gridDim.y * gridDim.z;
    unsigned sum, cnt, mine, sp = 0u;
    for (;;) {
        sum = 0u; cnt = 0u; mine = 0u;
#pragma unroll
        for (unsigned j = 0; j < 16; ++j) { const unsigned c = xb_ld(&bar[XB_XCNT(j)]); sum += c; cnt += (c > 0u) ? 1u : 0u; mine = (j == x) ? c : mine; }
        if (sum == G) break;
        __builtin_amdgcn_s_sleep(1);
        if ((++sp & 255u) == 0u) { if (xb_ld(&bar[XB_TMO])) break; if (sp > XB_SPIN_CAP) { atomicAdd(&bar[XB_TMO], 1u); break; } }
    }
    nloc = mine > 0u ? mine : 1u; nx = cnt > 0u ? cnt : 1u;
}
__device__ __forceinline__ void xcd_barrier(const XcdBarrier& b) {
    asm volatile("s_waitcnt vmcnt(0)" ::: "memory");
    __syncthreads();
    if (threadIdx.x == 0) {
        unsigned* bar = b.bar;
        __builtin_amdgcn_s_waitcnt(0);
        unsigned nloc = b.st[0], nx = b.st[1];
        if (nloc == 0u) { xcd_barrier_complete(bar, b.x, nloc, nx); b.st[0] = nloc; b.st[1] = nx; }
        const unsigned old = xb_add(&bar[XB_XSUB(b.x)], 1u);
        const unsigned gen = old / nloc;
        if (old + 1u == (gen + 1u) * nloc) {
            __builtin_amdgcn_fence(__ATOMIC_RELEASE, "agent");
            asm volatile("s_waitcnt vmcnt(0)" ::: "memory");
            const unsigned og = xb_add(&bar[XB_TOP], 1u);
            const unsigned tg = og / nx;
            if (og + 1u == (tg + 1u) * nx) xb_add(&bar[XB_TOPGEN], 1u);
            else XB_SPIN(xb_ld(&bar[XB_TOPGEN]) == tg, bar);
            __builtin_amdgcn_fence(__ATOMIC_ACQUIRE, "agent");
            xb_add(&bar[XB_XGEN(b.x)], 1u);
            asm volatile("s_waitcnt vmcnt(0)" ::: "memory");
        } else {
            XB_SPIN(xb_ld(&bar[XB_XGEN(b.x)]) == gen, bar);
            __builtin_amdgcn_fence(__ATOMIC_ACQUIRE, "agent");
            asm volatile("s_waitcnt vmcnt(0)" ::: "memory");
        }
    }
    __syncthreads();
}

struct Params {
    const float *x, *c, *ctx, *c_ctx, *ada_w, *ada_b, *norm_mix_g, *norm_mlp_g, *w_qkv, *qn_g, *kn_g, *attn_wo, *four_wo, *w1, *w2, *final_g;
    float* out; unsigned char* ws; int ph_lo, ph_hi;
};

template <bool F8 = false> __device__ __forceinline__ void transpose_item(const float* W, int K, int N, bf16_t* WT, LAS float* scr, int item, int lane) {
    const int nblk = N / 32, kb = item / nblk, nb = item % nblk, k0 = 64 * kb, n0 = 32 * nb;
#pragma unroll 8
    for (int i = 0; i < 32; ++i) { const int kk = 2 * i + (lane >> 5); scr[kk * 33 + (lane & 31)] = W[(size_t)(k0 + kk) * N + n0 + (lane & 31)]; }
    asm volatile("s_waitcnt lgkmcnt(0)" ::: "memory");
    const int c = lane & 7;
#pragma unroll
    for (int j = 0; j < 4; ++j) { const int n = (lane >> 3) + 8 * j; const LAS float* s = scr + (8 * c) * 33 + n;
        if constexpr (F8) { u32x2 o8; o8.x = pk4_fp8g(s[0 * 33] * 64.f, s[1 * 33] * 64.f, s[2 * 33] * 64.f, s[3 * 33] * 64.f); o8.y = pk4_fp8g(s[4 * 33] * 64.f, s[5 * 33] * 64.f, s[6 * 33] * 64.f, s[7 * 33] * 64.f);
            *(u32x2*)((unsigned char*)WT + (size_t)(n0 + n) * K + k0 + 8 * c) = o8; }
        else { u32x4 o; o.x = pk2(s[0 * 33], s[1 * 33]); o.y = pk2(s[2 * 33], s[3 * 33]); o.z = pk2(s[4 * 33], s[5 * 33]); o.w = pk2(s[6 * 33], s[7 * 33]);
            *(u32x4*)(WT + (size_t)(n0 + n) * K + k0 + 8 * c) = o; } }
    asm volatile("s_waitcnt lgkmcnt(0)" ::: "memory");
}

__device__ __forceinline__ void normmod_row(const float* xrow, const float* g, const float* sh, const float* sc, int lane, f32x4 (&y)[8]) {
    const f32x4* xr = (const f32x4*)xrow + lane; float s = 0.f;
#pragma unroll
    for (int j = 0; j < 8; ++j) { y[j] = xr[64 * j]; s += (y[j].x * y[j].x + y[j].y * y[j].y) + (y[j].z * y[j].z + y[j].w * y[j].w); }
    const float rstd = 1.0f / sqrtf(wave_sum(s) * (1.f / DM) + EPS);
#pragma unroll
    for (int j = 0; j < 8; ++j) { const f32x4 gg = ((const f32x4*)g)[lane + 64 * j], hh = ((const f32x4*)sh)[lane + 64 * j], cc = ((const f32x4*)sc)[lane + 64 * j];
        y[j] = y[j] * rstd * gg * (cc + 1.0f) + hh; }
}
struct RowMod { f32x4 gs[8], sh[8]; };
__device__ __forceinline__ void rowmod_load(RowMod& P, const float* g, const float* sh, const float* sc, int lane) {
#pragma unroll
    for (int j = 0; j < 8; ++j) { P.gs[j] = ((const f32x4*)g)[lane + 64 * j] * (((const f32x4*)sc)[lane + 64 * j] + 1.0f); P.sh[j] = ((const f32x4*)sh)[lane + 64 * j]; }
}
__device__ __forceinline__ void normmod_apply(f32x4 (&y)[8], float s, const RowMod& P) {
    const float rstd = 1.0f / sqrtf(wave_sum(s) * (1.f / DM) + EPS);
#pragma unroll
    for (int j = 0; j < 8; ++j) y[j] = y[j] * rstd * P.gs[j] + P.sh[j];
}
__device__ __forceinline__ void normmod_row_p(const float* xrow, const RowMod& P, int lane, f32x4 (&y)[8]) {
    const f32x4* xr = (const f32x4*)xrow + lane; float s = 0.f;
#pragma unroll
    for (int j = 0; j < 8; ++j) { y[j] = xr[64 * j]; s += (y[j].x * y[j].x + y[j].y * y[j].y) + (y[j].z * y[j].z + y[j].w * y[j].w); }
    normmod_apply(y, s, P);
}
__device__ __forceinline__ void normmod_row_bf_p(const bf16_t* xrow, const RowMod& P, int lane, f32x4 (&y)[8]) {
    const u32x2* xr = (const u32x2*)xrow + lane; float s = 0.f;
#pragma unroll
    for (int j = 0; j < 8; ++j) { const u32x2 w = xr[64 * j]; y[j] = (f32x4){bf_lo(w.x), bf_hi(w.x), bf_lo(w.y), bf_hi(w.y)}; s += (y[j].x * y[j].x + y[j].y * y[j].y) + (y[j].z * y[j].z + y[j].w * y[j].w); }
    normmod_apply(y, s, P);
}
__device__ __forceinline__ void normmod_row_bf(const bf16_t* xrow, const float* g, const float* sh, const float* sc, int lane, f32x4 (&y)[8]) {
    const u32x2* xr = (const u32x2*)xrow + lane; float s = 0.f;
#pragma unroll
    for (int j = 0; j < 8; ++j) { const u32x2 w = xr[64 * j]; y[j] = (f32x4){bf_lo(w.x), bf_hi(w.x), bf_lo(w.y), bf_hi(w.y)}; s += (y[j].x * y[j].x + y[j].y * y[j].y) + (y[j].z * y[j].z + y[j].w * y[j].w); }
    const float rstd = 1.0f / sqrtf(wave_sum(s) * (1.f / DM) + EPS);
#pragma unroll
    for (int j = 0; j < 8; ++j) { const f32x4 gg = ((const f32x4*)g)[lane + 64 * j], hh = ((const f32x4*)sh)[lane + 64 * j], cc = ((const f32x4*)sc)[lane + 64 * j];
        y[j] = y[j] * rstd * gg * (cc + 1.0f) + hh; }
}
__device__ __forceinline__ void store_row_fp8(unsigned char* orow, int lane, const f32x4 (&y)[8]) {
    unsigned* o4 = (unsigned*)orow + lane;
#pragma unroll
    for (int j = 0; j < 8; ++j) o4[64 * j] = pk4_fp8g(y[j].x, y[j].y, y[j].z, y[j].w);
}
__device__ __forceinline__ void store_row_bf16(bf16_t* orow, int lane, const f32x4 (&y)[8]) {
    u32x2* o8 = (u32x2*)orow + lane;
#pragma unroll
    for (int j = 0; j < 8; ++j) { u32x2 w; w.x = pk2(y[j].x, y[j].y); w.y = pk2(y[j].z, y[j].w); o8[64 * j] = w; }
}

__global__ void __launch_bounds__(512, 2) fwd_megakernel(Params p) {
    extern __shared__ __attribute__((aligned(16))) unsigned char lds[];
    LAS unsigned char* ldsl = (LAS unsigned char*)lds;
    const int tid = threadIdx.x, lane = tid & 63, wave = __builtin_amdgcn_readfirstlane(tid >> 6);
    const int G = gridDim.x, NGW = G * 8;
    unsigned char* ws = p.ws;
    float* mod = (float*)(ws + WS_MOD); float* ropec = (float*)(ws + WS_ROPE); float* ropes = ropec + 64 * 32;
    bf16_t* C256 = (bf16_t*)(ws + WS_C256); bf16_t* S256 = (bf16_t*)(ws + WS_S256);
    float* hny = (float*)(ws + WS_HNY); float* zfix = (float*)(ws + WS_ZFIX);
    bf16_t* Wqkv_t = (bf16_t*)(ws + WS_WQKV); bf16_t* Wo_t = (bf16_t*)(ws + WS_WO); bf16_t* Wf_t = (bf16_t*)(ws + WS_WF);
    bf16_t* Hb = (bf16_t*)(ws + WS_H); bf16_t* ACT = (bf16_t*)(ws + WS_ACT);
    bf16_t* Qb = (bf16_t*)(ws + WS_Q); bf16_t* Kb = (bf16_t*)(ws + WS_K); bf16_t* Vb = (bf16_t*)(ws + WS_V); bf16_t* Ob = (bf16_t*)(ws + WS_O);
    bf16_t* XB = (bf16_t*)(ws + WS_XB); bf16_t* Ub = (bf16_t*)(ws + WS_U); bf16_t* ZT = (bf16_t*)(ws + WS_ZT); bf16_t* Yb = (bf16_t*)(ws + WS_Y);
    const int lo = p.ph_lo, hi = p.ph_hi;
#ifndef PH_MASK
#define PH_MASK 0x1FFFF
#endif
#define INM(k, id) (((PH_MASK >> (id)) & 1) && lo <= (k) && (k) < hi)
#define IN(k) INM(k, k)
#ifndef PROBE_REPEAT
#define PROBE_REPEAT -1
#endif
#define REP(id) for (int rep_ = 0; rep_ < ((PROBE_REPEAT == (id)) ? 2 : 1); ++rep_)
#define SEAM(k) do { if (lo <= (k) && (k) + 1 < hi) xcd_barrier(xbar); } while (0)
    volatile LAS unsigned* misc = (volatile LAS unsigned*)(ldsl + LDS_MISC);
    if (tid < 4) misc[tid] = 0u;
    __syncthreads();
    XcdBarrier xbar; xbar.bar = (unsigned*)(ws + WS_CTL); xbar.x = 0; xbar.st = misc;
    if (hi - lo > 1) {
        unsigned* bar = xbar.bar; xbar.x = xb_xcc_id();
        if (tid == 0) {
            const unsigned rank = xb_add(&bar[XB_XCNT(xbar.x)], 1u);
            unsigned nloc, nx; xcd_barrier_complete(bar, xbar.x, nloc, nx); misc[0] = nloc; misc[1] = nx;
            bool uni = (nx == 8u) && (nloc * 8u == (unsigned)G) && (xbar.x < 8u) && (rank < nloc);
#pragma unroll
            for (unsigned j = 0; j < 16; ++j) { const unsigned c = xb_ld(&bar[XB_XCNT(j)]); if (j < 8 ? (c * 8u != (unsigned)G) : (c != 0u)) uni = false; }
            misc[2] = uni ? (rank * 8u + xbar.x + 1u) : 0u;
        }
        __syncthreads();
    }
    const unsigned vw_ = misc[2];
    const int wg = __builtin_amdgcn_readfirstlane(vw_ ? (int)(vw_ - 1u) : (int)blockIdx.x);
    const int gw = wg * 8 + wave;
    if (lo == -12345) cg::this_grid().sync();

    REP(0) if (IN(0)) {
        {
            LAS float* scr = (LAS float*)(ldsl + wave * 16384);
            constexpr int I_QKV = (DM / 64) * (QKVD / 32), I_O = (DM / 64) * (DM / 32), I_1 = (DM / 64) * (DFF / 32), I_2 = (DFF / 64) * (DM / 32);
            constexpr int NITEMS = I_QKV + 2 * I_O + 2 * I_1 + 2 * I_2;
            for (int it = gw; it < NITEMS; it += NGW) {
                int r = it;
                if (r < I_QKV) { transpose_item<true>(p.w_qkv, DM, QKVD, Wqkv_t, scr, r, lane); continue; } r -= I_QKV;
                if (r < I_O) { transpose_item<true>(p.attn_wo, DM, DM, Wo_t, scr, r, lane); continue; } r -= I_O;
                if (r < I_O) { transpose_item(p.four_wo, DM, DM, Wf_t, scr, r, lane); continue; } r -= I_O;
                if (r < I_1) { transpose_item(p.w1, DM, DFF, (bf16_t*)(ws + WS_W1A), scr, r, lane); continue; } r -= I_1;
                if (r < I_1) { transpose_item(p.w1 + (size_t)DM * DFF, DM, DFF, (bf16_t*)(ws + WS_W1B), scr, r, lane); continue; } r -= I_1;
                if (r < I_2) { transpose_item(p.w2, DFF, DM, (bf16_t*)(ws + WS_W2A), scr, r, lane); continue; } r -= I_2;
                transpose_item(p.w2 + (size_t)DM * DFF, DFF, DM, (bf16_t*)(ws + WS_W2B), scr, r, lane);
            }
        }
        __syncthreads();
        {
            LAS float* tab = (LAS float*)ldsl;
            for (int m = tid; m < 4096; m += 512) tab[m] = cospif((float)m * (1.0f / 2048.0f)) * (1.0f / 64.0f);
            __syncthreads();
            bf16_t* Tc = (bf16_t*)(ws + WS_T); bf16_t* Ts = (bf16_t*)(ws + WS_T + 8 * MiB);
            for (int k = wg; k < 2048; k += G) {
                const int j0 = (tid * 8) & 2047; const bool sn = tid >= 256; float v[8];
#pragma unroll
                for (int e = 0; e < 8; ++e) v[e] = tab[((k * (j0 + e)) + (sn ? 3072 : 0)) & 4095];
                u32x4 w; w.x = pk2(v[0], v[1]); w.y = pk2(v[2], v[3]); w.z = pk2(v[4], v[5]); w.w = pk2(v[6], v[7]);
                *(u32x4*)((sn ? Ts : Tc) + (size_t)k * 2048 + j0) = w;
            }
            __syncthreads();
        }
        {
            for (int idx = wg * 512 + tid; idx < 2 * 65536; idx += G * 512) {
                const int which = idx >> 16, e = idx & 65535, kc = e >> 8, cc = e & 255; const float a = (float)((kc * cc) & 255) * (1.0f / 128.0f);
                const float v = (which ? sinpif(a) : cospif(a)) * (1.0f / 16.0f);
                (which ? S256 : C256)[e] = (bf16_t)f2bf(v);
            }
            for (int idx = wg * 512 + tid; idx < 2048; idx += G * 512) {
                const int pos = idx >> 5, f = idx & 31; const float inv = powf(10000.0f, -(float)f / 32.0f), ang = (float)pos * inv;
                ropec[idx] = cosf(ang); ropes[idx] = sinf(ang);
            }
        }
        for (int un = wg; un < 192; un += G) {
            const int l = un / 96, cb = un % 96;
            LAS float* sl = (LAS float*)ldsl;
            LAS float* red = (LAS float*)(ldsl + 65536);
            __syncthreads();
            for (int i = tid; i < DM * 5; i += 512) { const int k = i / 5, r = i % 5; const float v = r < 4 ? p.c[r * DM + k] : p.c_ctx[k]; sl[i] = v / (1.0f + __expf(-v)); }
            __syncthreads();
            const int hw = tid >> 5, l32 = tid & 31;
            const float* wp = p.ada_w + (size_t)l * DM * NMOD + cb * 128 + l32 * 4;
            f32x4 a0 = {0, 0, 0, 0}, a1 = a0, a2 = a0, a3 = a0, a4 = a0;
#pragma unroll 8
            for (int kk = 0; kk < 128; ++kk) { const int k = kk * 16 + hw; const f32x4 w = *(const f32x4*)(wp + (size_t)k * NMOD);
                const LAS float* s = sl + k * 5; a0 += w * s[0]; a1 += w * s[1]; a2 += w * s[2]; a3 += w * s[3]; a4 += w * s[4]; }
            *(LAS f32x4*)(red + (hw * 5 + 0) * 128 + l32 * 4) = a0; *(LAS f32x4*)(red + (hw * 5 + 1) * 128 + l32 * 4) = a1; *(LAS f32x4*)(red + (hw * 5 + 2) * 128 + l32 * 4) = a2;
            *(LAS f32x4*)(red + (hw * 5 + 3) * 128 + l32 * 4) = a3; *(LAS f32x4*)(red + (hw * 5 + 4) * 128 + l32 * 4) = a4;
            __syncthreads();
            for (int idx = tid; idx < 640; idx += 512) { const int r = idx >> 7, cc = idx & 127; float sum = p.ada_b[l * NMOD + cb * 128 + cc];
#pragma unroll
                for (int h = 0; h < 16; ++h) sum += red[(h * 5 + r) * 128 + cc];
                mod[(size_t)(l * 5 + r) * NMOD + cb * 128 + cc] = sum; }
        }
    }
    SEAM(0);

    REP(1) if (IN(1)) {
        const int rpw = (MLAT + NGW - 1) / NGW;
        { RowMod P; int bl = -1;
          for (int m = gw * rpw; m < (gw + 1) * rpw && m < MLAT; ++m) { const int r = m / SEQ;
            if (r != bl) { rowmod_load(P, p.norm_mix_g, mod + (size_t)r * NMOD, mod + (size_t)r * NMOD + DM, lane); bl = r; }
            f32x4 y[8]; normmod_row_p(p.x + (size_t)m * DM, P, lane, y);
            store_row_fp8((unsigned char*)Hb + (size_t)m * DM, lane, y); } }
        { RowMod P; rowmod_load(P, p.norm_mix_g, mod + (size_t)4 * NMOD, mod + (size_t)4 * NMOD + DM, lane);
          for (int m = gw; m < MCTX; m += NGW) { f32x4 y[8]; normmod_row_p(p.ctx + (size_t)m * DM, P, lane, y);
            store_row_fp8((unsigned char*)Hb + (size_t)(MLAT + m) * DM, lane, y); } }
    }
    SEAM(1);

    REP(2) if (IN(2)) {
        pg8::SchedQKV S{(const char*)Hb, (const char*)Wqkv_t, G, wg};
        pg8::EpiBf16<0> E{Qb, Kb, Vb, DM, KVD, 1};
        pg8::gemm_phase_t<true, 0x79797979, 0x7f7f7f7f>(ldsl, DM / 128, DM, DM, S, E);
    }
    SEAM(2);

    if (IN(3)) {
        unsigned char* K8 = ws + WS_K8; unsigned char* V8 = ws + WS_V8;
        LAS unsigned char* vt = ldsl + wave * 8192;
        const int l16 = lane & 15, kq = lane >> 4, d0 = l16 * 8;
        const f32x4 g0 = *(const f32x4*)(p.kn_g + d0), g1 = *(const f32x4*)(p.kn_g + d0 + 4);
        for (int un = gw; un < NB * NKV * (SKV / 64); un += NGW) {
            const int tile = un % (SKV / 64), bh = un / (SKV / 64), b = bh / NKV, head = bh % NKV;
            const size_t tb = (size_t)un * 8192;
#pragma unroll 4
            for (int it = 0; it < 16; ++it) {
                const int i = it * 4 + kq, j = tile * 64 + i; const size_t src = ((size_t)(b * SKV + j)) * KVD + head * HD + d0;
                const u32x4 raw = *(const u32x4*)(Kb + src); const u32x4 rawv = *(const u32x4*)(Vb + src);
                float v[8];
#pragma unroll
                for (int e = 0; e < 4; ++e) { v[2 * e] = bf_lo(raw[e]); v[2 * e + 1] = bf_hi(raw[e]); }
                float ss = 0.f;
#pragma unroll
                for (int e = 0; e < 8; ++e) ss += v[e] * v[e];
                ss += __shfl_xor(ss, 1); ss += __shfl_xor(ss, 2); ss += __shfl_xor(ss, 4); ss += __shfl_xor(ss, 8);
                const float rstd = 1.0f / sqrtf(ss * (1.f / 128.f) + EPS);
#pragma unroll
                for (int e = 0; e < 4; ++e) { v[e] *= rstd * g0[e]; v[4 + e] *= rstd * g1[e]; }
                if (j < SEQ) {
                    const int i0 = l16 * 4, pos = i0 < 32 ? tile : i, f0 = i0 & 31;
                    const f32x4 c4 = *(const f32x4*)(ropec + pos * 32 + f0), s4 = *(const f32x4*)(ropes + pos * 32 + f0);
#pragma unroll
                    for (int e = 0; e < 4; ++e) { const float y0 = v[2 * e], y1 = v[2 * e + 1]; v[2 * e] = y0 * c4[e] - y1 * s4[e]; v[2 * e + 1] = y0 * s4[e] + y1 * c4[e]; }
                }
                { u32x2 w; w.x = att8::pk4_fp8(v[0], v[1], v[2], v[3]); w.y = att8::pk4_fp8(v[4], v[5], v[6], v[7]);
                  *(u32x2*)(K8 + tb + i * 128 + 16 * ((d0 >> 4) ^ ((i >> 1) & 7)) + (d0 & 15)) = w; }
                { const int slot = ((i >> 2) & 1) * 32 + (i & 3) + 4 * ((i & 31) >> 3) + 16 * (i >> 5);
                  const unsigned w0 = att8::pk4_fp8(bf_lo(rawv[0]), bf_hi(rawv[0]), bf_lo(rawv[1]), bf_hi(rawv[1])), w1 = att8::pk4_fp8(bf_lo(rawv[2]), bf_hi(rawv[2]), bf_lo(rawv[3]), bf_hi(rawv[3]));
#pragma unroll
                  for (int e = 0; e < 8; ++e) { const int d = d0 + e; const unsigned by = ((e < 4 ? w0 : w1) >> (8 * (e & 3))) & 0xffu;
                      vt[d * 64 + 16 * ((slot >> 4) ^ ((d >> 2) & 3)) + (slot & 15)] = (unsigned char)by; } }
            }
            asm volatile("s_waitcnt lgkmcnt(0)" ::: "memory");
#pragma unroll
            for (int q = 0; q < 8; ++q) *(u32x4*)(V8 + tb + (q * 64 + lane) * 16) = *(const LAS u32x4*)(vt + (q * 64 + lane) * 16);
            asm volatile("s_waitcnt lgkmcnt(0)" ::: "memory");
        }
    }
    SEAM(3);

    REP(4) if (IN(4)) {
        const int nper = G / 8;
        const int xcd = wg % 8, wl = wg / 8;
        for (int idx = wl; idx < 128; idx += nper) {
            const int grp = xcd + 8 * (idx / 64), b = grp / NKV, kvh = grp % NKV, ui = idx % 64, h = kvh * 4 + ui / 16, qb = ui % 16;
            const bf16_t* q = (const bf16_t*)((const unsigned char*)Qb + ((size_t)(b * SEQ + qb * 256)) * DM + h * HD);
            const unsigned char* k8 = ws + WS_K8 + (size_t)((b * NKV + kvh) * (SKV / 64)) * 8192; const unsigned char* v8 = ws + WS_V8 + (size_t)((b * NKV + kvh) * (SKV / 64)) * 8192;
            bf16_t* o = (bf16_t*)((unsigned char*)Ob + ((size_t)(b * SEQ + qb * 256)) * DM + h * HD);
            att8::attn_body(q, k8, v8, o, SKV / 64, qb * 256, p.qn_g, ropec, ropes, ldsl);
        }
    }
    SEAM(4);

    if (IN(5)) {
        pg8::SchedStd S{(const char*)Ob, (const char*)Wo_t, MLAT / 256, DM / 256, G, wg, (size_t)256 * DM, (size_t)256 * DM};
        pg8::EpiResid<false> E{p.x, XB, mod + 2 * DM};
        pg8::gemm_phase_t<true, 0x79797979, 0x7a7a7a7a>(ldsl, DM / 128, DM, DM, S, E);
    }
    SEAM(5);

#define MLP_BLOCK(l, pb) do { \
    if (INM(pb, 6)) { \
        const int rpw = (MLAT + NGW - 1) / NGW; RowMod P; int bl = -1; \
        for (int m = gw * rpw; m < (gw + 1) * rpw && m < MLAT; ++m) { const int r = m / SEQ; \
            if (r != bl) { rowmod_load(P, p.norm_mlp_g + l * DM, mod + (size_t)(l * 5 + r) * NMOD + 3 * DM, mod + (size_t)(l * 5 + r) * NMOD + 4 * DM, lane); bl = r; } \
            f32x4 y[8]; normmod_row_bf_p(XB + (size_t)m * DM, P, lane, y); \
            store_row_bf16(Hb + (size_t)m * DM, lane, y); \
        } \
    } \
    SEAM(pb); \
    REP(7 + 100 * l) if (INM(pb + 1, 7)) { \
        pg8::SchedStd S{(const char*)Hb, (const char*)(ws + (l == 0 ? WS_W1A : WS_W1B)), MLAT / 256, DFF / 256, G, wg, (size_t)256 * DM * 2, (size_t)256 * DM * 2}; \
        pg8::EpiBf16<1> E{ACT, ACT, ACT, DFF, DFF}; \
        pg8::gemm_phase(ldsl, DM, DM, DM, S, E); \
    } \
    SEAM(pb + 1); \
    if (INM(pb + 2, 8)) { \
        pg8::SchedStd S{(const char*)ACT, (const char*)(ws + (l == 0 ? WS_W2A : WS_W2B)), MLAT / 256, DM / 256, G, wg, (size_t)256 * DFF * 2, (size_t)256 * DFF * 2, 4}; \
        pg8::EpiResid<true> E{nullptr, XB, mod + (size_t)l * 5 * NMOD + 5 * DM}; \
        pg8::gemm_phase(ldsl, DFF, DFF, DFF, S, E); \
    } \
    SEAM(pb + 2); \
    } while (0)
    MLP_BLOCK(0, 6);
    if (IN(9)) {
        RowMod P; int bl = -1;
        for (int t = gw; t < NB * 2049; t += NGW) {
            const int b = t & 3, n = t >> 2;
            if (b != bl) { rowmod_load(P, p.norm_mix_g + DM, mod + (size_t)(5 + b) * NMOD, mod + (size_t)(5 + b) * NMOD + DM, lane); bl = b; }
            f32x4 y[8]; normmod_row_bf_p(XB + ((size_t)b * SEQ + n) * DM, P, lane, y);
            if (n == 0) store_row_bf16(Ub + ((size_t)b * SEQ) * DM, lane, y);
            else if (n == 2048) {
#pragma unroll
                for (int j = 0; j < 8; ++j) { ((f32x4*)(hny + b * DM))[lane + 64 * j] = y[j]; y[j] = (f32x4){0.f, 0.f, 0.f, 0.f}; }
                store_row_bf16(Ub + ((size_t)b * SEQ + 2048) * DM, lane, y);
            } else {
                f32x4 z[8]; normmod_row_bf_p(XB + ((size_t)b * SEQ + (SEQ - n)) * DM, P, lane, z);
                f32x4 sm[8];
#pragma unroll
                for (int j = 0; j < 8; ++j) { sm[j] = y[j] + z[j]; z[j] = y[j] - z[j]; }
                store_row_bf16(Ub + ((size_t)b * SEQ + n) * DM, lane, sm);
                store_row_bf16(Ub + ((size_t)b * SEQ + 2048 + n) * DM, lane, z);
            }
        }
    }
    SEAM(9);
    REP(10) if (IN(10)) {
        for (int un = wg; un < 32; un += G) {
            LAS float* hrow = (LAS float*)(ldsl + 131072); LAS float* ctab = hrow + 256;
            const int b = un >> 3, g = un & 7;
            __syncthreads();
            if (tid < 256) { hrow[tid] = hny[b * DM + g * 256 + tid]; ctab[tid] = cospif((float)tid * (1.0f / 128.0f)) * (1.0f / 16.0f); }
            __syncthreads();
            const int kc = tid >> 1, c0 = (tid & 1) * 128; float s = 0.f;
            for (int cc = c0; cc < c0 + 128; ++cc) s += ctab[(kc * cc) & 255] * hrow[cc];
            s += __shfl_xor(s, 1);
            if ((tid & 1) == 0) zfix[b * DM + g * 256 + kc] = s;
        }
        __syncthreads();
        pg8::SchedChan S{(const char*)C256, (const char*)S256, (const char*)Ub, G, wg};
        pg8::EpiBf16<0> E{ZT, ZT, ZT, 4096, 4096};
        pg8::gemm_phase(ldsl, 256, 256, DM, S, E);
    }
    SEAM(10);
    REP(11) if (IN(11)) {
        for (int r = gw; r < NB * DM; r += NGW) {
            const u32x4* zr = (const u32x4*)(ZT + (size_t)r * 4096) + lane; float sacc = 0.f;
#pragma unroll
            for (int q = 0; q < 4; ++q) { const u32x4 w = zr[64 * q];
#pragma unroll
                for (int e = 0; e < 4; ++e) sacc += bf_lo(w[e]) - bf_hi(w[e]); }
            sacc = wave_sum(sacc);
            if (lane == 0) Yb[((size_t)(r >> 11) * SEQ + 2048) * DM + (r & 2047)] = (bf16_t)f2bf((sacc + zfix[r]) * (1.0f / 64.0f));
        }
        pg8::SchedSeq2 S{(const char*)(ws + WS_T), (const char*)ZT, G, wg};
        pg8::EpiSeq2 E{Yb, (bf16_t*)(ws + WS_PT), zfix};
        pg8::gemm_phase(ldsl, 2048, 2048, 4096, S, E);
    }
    SEAM(11);
    if (IN(12)) {
        pg8::SchedStd S{(const char*)Yb, (const char*)Wf_t, MLAT / 256, DM / 256, G, wg, (size_t)256 * DM * 2, (size_t)256 * DM * 2};
        pg8::EpiResid<true> E{nullptr, XB, mod + (size_t)5 * NMOD + 2 * DM};
        pg8::gemm_phase(ldsl, DM, DM, DM, S, E);
    }
    SEAM(12);
    MLP_BLOCK(1, 13);
    if (IN(16)) {
        f32x4 fg[8];
#pragma unroll
        for (int j = 0; j < 8; ++j) fg[j] = ((const f32x4*)p.final_g)[lane + 64 * j];
        for (int m = gw; m < MLAT; m += NGW) {
            const u32x2* xr = (const u32x2*)(XB + (size_t)m * DM) + lane; f32x4* orow = (f32x4*)(p.out + (size_t)m * DM) + lane; f32x4 y[8]; float s = 0.f;
#pragma unroll
            for (int j = 0; j < 8; ++j) { const u32x2 w = xr[64 * j]; y[j] = (f32x4){bf_lo(w.x), bf_hi(w.x), bf_lo(w.y), bf_hi(w.y)}; s += (y[j].x * y[j].x + y[j].y * y[j].y) + (y[j].z * y[j].z + y[j].w * y[j].w); }
            const float rstd = 1.0f / sqrtf(wave_sum(s) * (1.f / DM) + EPS);
#pragma unroll
            for (int j = 0; j < 8; ++j) orow[64 * j] = y[j] * rstd * fg[j];
        }
    }
#undef IN
#undef INM
#undef SEAM
}

extern "C" void kernel_launch(void* const* d_in, const int* in_sizes, int n_in, void* d_out, int out_size, void* d_ws, size_t ws_size, hipStream_t stream) {
    static int grid = 0;
    if (grid == 0) {
        if (n_in != 16 || out_size != MLAT * DM || ws_size < WS_END) { fprintf(stderr, "kernel_launch: unexpected shapes (n_in %d out %d ws %zu)\n", n_in, out_size, ws_size); grid = -1; return; }
        int dev = 0, cus = 0, per_cu = 0;
        hipGetDevice(&dev); hipDeviceGetAttribute(&cus, hipDeviceAttributeMultiprocessorCount, dev);
        if (hipFuncSetAttribute((const void*)fwd_megakernel, hipFuncAttributeMaxDynamicSharedMemorySize, LDS_BYTES) != hipSuccess) { fprintf(stderr, "kernel_launch: hipFuncSetAttribute failed\n"); grid = -1; return; }
        if (hipOccupancyMaxActiveBlocksPerMultiprocessor(&per_cu, (const void*)fwd_megakernel, 512, LDS_BYTES) != hipSuccess || per_cu < 1) { fprintf(stderr, "kernel_launch: occupancy query says %d\n", per_cu); per_cu = 1; }
        (void)hipGetLastError();
        grid = cus * 1;
        if (grid % 8 != 0 || grid <= 0) { fprintf(stderr, "kernel_launch: unexpected CU count %d\n", cus); grid = -1; return; }
    }
    if (grid < 0) return;
    Params p{};
    p.x = (const float*)d_in[0]; p.c = (const float*)d_in[1]; p.ctx = (const float*)d_in[2]; p.c_ctx = (const float*)d_in[3];
    p.ada_w = (const float*)d_in[4]; p.ada_b = (const float*)d_in[5]; p.norm_mix_g = (const float*)d_in[6]; p.norm_mlp_g = (const float*)d_in[7];
    p.w_qkv = (const float*)d_in[8]; p.qn_g = (const float*)d_in[9]; p.kn_g = (const float*)d_in[10]; p.attn_wo = (const float*)d_in[11];
    p.four_wo = (const float*)d_in[12]; p.w1 = (const float*)d_in[13]; p.w2 = (const float*)d_in[14]; p.final_g = (const float*)d_in[15];
    p.out = (float*)d_out; p.ws = (unsigned char*)d_ws;
#if MK_MULTI_LAUNCH
    for (int ph = 0; ph < NPHASE; ++ph) {
        p.ph_lo = ph; p.ph_hi = ph + 1;
        hipLaunchKernelGGL(fwd_megakernel, dim3(grid), dim3(512), LDS_BYTES, stream, p);
    }
#else
    p.ph_lo = 0; p.ph_hi = NPHASE;
    if (hipMemsetAsync((char*)d_ws + WS_CTL, 0, CTL_ZERO_BYTES, stream) != hipSuccess) { fprintf(stderr, "kernel_launch: memset failed\n"); return; }
    void* args[] = {&p};
    hipError_t e = hipLaunchCooperativeKernel((const void*)fwd_megakernel, dim3(grid), dim3(512), args, LDS_BYTES, stream);
    if (e != hipSuccess) fprintf(stderr, "kernel_launch: cooperative launch failed: %s (grid %d)\n", hipGetErrorString(e), grid);
#endif
}
```

```cpp
#include <hip/hip_runtime.h>
#include <hip/hip_cooperative_groups.h>
#include <cstdio>
#include <cstdint>
namespace cg = cooperative_groups;

#ifndef MK_MULTI_LAUNCH
#define MK_MULTI_LAUNCH 0
#endif

#define LAS __attribute__((address_space(3)))
typedef unsigned short bf16_t;
typedef short bf16x8 __attribute__((ext_vector_type(8)));
typedef short s16x4 __attribute__((ext_vector_type(4)));
typedef float f32x4 __attribute__((ext_vector_type(4)));
typedef float f32x2 __attribute__((ext_vector_type(2)));
typedef float f32x16 __attribute__((ext_vector_type(16)));
typedef unsigned u32x4 __attribute__((ext_vector_type(4)));
typedef unsigned u32x2 __attribute__((ext_vector_type(2)));

constexpr int DM = 2048, NB = 4, SEQ = 4096, CTXL = 256, NH = 16, NKV = 4, HD = 128, KVD = NKV * HD, QKVD = DM + 2 * KVD, DFF = 8192;
constexpr int MLAT = NB * SEQ, MCTX = NB * CTXL, MALL = MLAT + MCTX, SKV = SEQ + CTXL, NMOD = 6 * DM;
constexpr float EPS = 1e-6f;
constexpr int NPHASE = 17;

constexpr size_t MiB = 1u << 20;
constexpr size_t WS_MOD = 1 * MiB;
constexpr size_t WS_ROPE = WS_MOD + 512 * 1024;
constexpr size_t WS_C256 = WS_ROPE + 64 * 1024;
constexpr size_t WS_S256 = WS_C256 + 128 * 1024;
constexpr size_t WS_HNY = WS_S256 + 128 * 1024;
constexpr size_t WS_ZFIX = WS_HNY + 32 * 1024;
constexpr size_t WS_WQKV = 4 * MiB, WS_WO = 16 * MiB, WS_WF = 24 * MiB, WS_W1A = 32 * MiB, WS_W2A = 64 * MiB, WS_W1B = 96 * MiB, WS_W2B = 128 * MiB;
constexpr size_t WS_T = 160 * MiB;
constexpr size_t WS_H = 192 * MiB;
constexpr size_t WS_ACT = 260 * MiB;
constexpr size_t WS_Q = WS_ACT, WS_K = WS_ACT + 64 * MiB, WS_V = WS_K + 17 * MiB, WS_O = WS_V + 17 * MiB;
constexpr size_t WS_K8 = WS_ACT + 164 * MiB, WS_V8 = WS_ACT + 174 * MiB;
constexpr size_t WS_U = WS_ACT, WS_ZT = WS_ACT + 64 * MiB, WS_Y = WS_ACT + 128 * MiB, WS_PT = WS_ACT + 192 * MiB;
constexpr size_t WS_XB = WS_ACT + 256 * MiB;
constexpr size_t WS_END = WS_XB + 64 * MiB;
static_assert(WS_ZFIX + 32 * 1024 <= WS_WQKV && WS_O + 64 * MiB <= WS_END && WS_Y + 64 * MiB <= WS_END, "ws map");

constexpr int LDS_BYTES = 147456;
constexpr int LDS_MISC = 139264;
constexpr size_t WS_CTL = 0, CTL_ZERO_BYTES = 16384;

__device__ __forceinline__ unsigned f2bf(float f) { unsigned u = __builtin_bit_cast(unsigned, f); return (u + 0x7fffu + ((u >> 16) & 1u)) >> 16; }
__device__ __forceinline__ unsigned cvt_pk_bf16(float lo, float hi) { unsigned r; asm volatile("v_cvt_pk_bf16_f32 %0, %1, %2" : "=v"(r) : "v"(lo), "v"(hi)); return r; }
__device__ __forceinline__ unsigned pk2(float lo, float hi) { unsigned r; asm("v_cvt_pk_bf16_f32 %0, %1, %2" : "=v"(r) : "v"(lo), "v"(hi)); return r; }
__device__ __forceinline__ float bf_lo(unsigned w) { return __builtin_bit_cast(float, w << 16); }
__device__ __forceinline__ float bf_hi(unsigned w) { return __builtin_bit_cast(float, w & 0xffff0000u); }
__device__ __forceinline__ unsigned pk4_fp8g(float a, float b, float c, float d) { unsigned w;
    asm("v_cvt_pk_fp8_f32 %0, %1, %2" : "=v"(w) : "v"(a), "v"(b)); asm("v_cvt_pk_fp8_f32 %0, %1, %2 op_sel:[0,0,1]" : "+v"(w) : "v"(c), "v"(d)); return w; }
__device__ __forceinline__ float wave_sum(float v) {
#pragma unroll
    for (int o = 1; o < 64; o <<= 1) v += __shfl_xor(v, o);
    return v;
}

namespace pg8 {
constexpr int BM = 256, BK = 64, HALF = 128, HTB = HALF * BK * 2, STAGE_BYTES = 8 * HTB, NXCD = 8, WGM = 8;
__host__ __device__ __forceinline__ int lds_byte(int r, int c) { const int st = (r >> 4) * 2 + (c >> 5), rr = r & 15, cc = c & 31, ob = rr * 64 + cc * 2; return st * 1024 + (ob ^ (((ob >> 9) & 1) << 5)); }
__host__ __device__ __forceinline__ void stage_rc(int b, int& R, int& C) { const int st = b / 1024, sb = b % 1024, swz = sb ^ (((sb >> 9) & 1) << 5); R = (st >> 1) * 16 + swz / 64; C = (st & 1) * 32 + (swz % 64) / 2; }
__host__ __device__ __forceinline__ int perm32(int rho) { const int n = rho >> 4, i = rho & 15; return 8 * (i >> 2) + 4 * n + (i & 3); }

struct Unit { const char* a; const char* b; int orow, ocol, sel, aux; };

__device__ __forceinline__ void tile_map(int wgid, int nM, int nN, int& pm, int& pn, const int WGM = 8) {
    const int nwg = nM * nN;
    { const int q = nwg / NXCD, r = nwg % NXCD, xcd = wgid % NXCD, off = wgid / NXCD; wgid = (xcd < r ? xcd * (q + 1) : r * (q + 1) + (xcd - r) * q) + off; }
    const int nig = WGM * nN, gid = wgid / nig, fm = gid * WGM, gsz = (nM - fm) < WGM ? (nM - fm) : WGM;
    pm = fm + ((wgid % nig) % gsz); pn = (wgid % nig) / gsz;
}

typedef int v8i_t __attribute__((ext_vector_type(8)));
typedef int v4i_t __attribute__((ext_vector_type(4)));
__device__ __forceinline__ v8i_t cat8(bf16x8 lo, bf16x8 hi) { const v4i_t a = __builtin_bit_cast(v4i_t, lo), b = __builtin_bit_cast(v4i_t, hi); v8i_t r; r[0] = a.x; r[1] = a.y; r[2] = a.z; r[3] = a.w; r[4] = b.x; r[5] = b.y; r[6] = b.z; r[7] = b.w; return r; }
template <bool FP8, int WSC, int ASC, class Epi, class Sched>
__device__ __forceinline__ void gemm_phase_t(LAS unsigned char* lds, const int nt, const int ldaB, const int ldbB, const Sched& S, const Epi& E) {
    int tid_o = threadIdx.x; asm volatile("" : "+v"(tid_o));
    const int tid = tid_o, wid = __builtin_amdgcn_readfirstlane(tid >> 6), lane = tid & 63, wr = wid >> 2, wc = wid & 3, fr = lane & 15, fq = lane >> 4;
    unsigned voffA[2], voffB[2];
#pragma unroll
    for (int i = 0; i < 2; ++i) { int R, C; stage_rc(tid * 16 + i * 8192, R, C); const int Rb = Epi::PERM ? ((R & ~31) + perm32(R & 31)) : R;
        voffA[i] = (unsigned)(R * ldaB + C * 2); voffB[i] = (unsigned)(Rb * ldbB + C * 2); }
    const size_t kstep = (size_t)(BK * 2);
    const size_t hstepA = (size_t)HALF * ldaB, hstepB = (size_t)HALF * ldbB;
    const unsigned ldsw = (unsigned)wid * 1024u;
    const int aoff = lds_byte(wr * 64 + fr, fq * 8), boff = lds_byte(wc * 32 + fr, fq * 8);
#define PG8_SA(b, h) (((b) * 2 + (h)) * HTB)
#define PG8_SB(b, h) ((4 + (b) * 2 + (h)) * HTB)
#define PG8_STAGE(bufoff, gbase, voff) do { _Pragma("unroll") for (int _i = 0; _i < 2; ++_i) \
        __builtin_amdgcn_global_load_lds((const unsigned*)((const char*)(gbase) + (voff)[_i]), (LAS unsigned*)(lds + (bufoff) + ldsw + _i * 8192), 16, 0, 0); } while (0)
#define PG8_LD16(off) (*(const LAS v4i_t*)(lds + (off)))
#define PG8_LDA(dst, b, h) do { if constexpr (FP8) { _Pragma("unroll") for (int m = 0; m < 4; ++m) { const v4i_t x_ = PG8_LD16(PG8_SA(b, h) + aoff + m * 2048), y_ = PG8_LD16(PG8_SA(b, h) + aoff + m * 2048 + 1024); \
            dst##8[m][0] = x_.x; dst##8[m][1] = x_.y; dst##8[m][2] = x_.z; dst##8[m][3] = x_.w; dst##8[m][4] = y_.x; dst##8[m][5] = y_.y; dst##8[m][6] = y_.z; dst##8[m][7] = y_.w; } } \
        else { _Pragma("unroll") for (int m = 0; m < 4; ++m) _Pragma("unroll") for (int k = 0; k < 2; ++k) dst[m][k] = *(const LAS bf16x8*)(lds + PG8_SA(b, h) + aoff + m * 2048 + k * 1024); } } while (0)
#define PG8_LDB(dst, b, h) do { if constexpr (FP8) { _Pragma("unroll") for (int n = 0; n < 2; ++n) { const v4i_t x_ = PG8_LD16(PG8_SB(b, h) + boff + n * 2048), y_ = PG8_LD16(PG8_SB(b, h) + boff + n * 2048 + 1024); \
            dst##8[n][0] = x_.x; dst##8[n][1] = x_.y; dst##8[n][2] = x_.z; dst##8[n][3] = x_.w; dst##8[n][4] = y_.x; dst##8[n][5] = y_.y; dst##8[n][6] = y_.z; dst##8[n][7] = y_.w; } } \
        else { _Pragma("unroll") for (int n = 0; n < 2; ++n) _Pragma("unroll") for (int k = 0; k < 2; ++k) dst[n][k] = *(const LAS bf16x8*)(lds + PG8_SB(b, h) + boff + n * 2048 + k * 1024); } } while (0)
#define PG8_MMA(ai, bj, At, Bt) do { __builtin_amdgcn_s_setprio(1); if constexpr (FP8) { _Pragma("unroll") for (int m = 0; m < 4; ++m) _Pragma("unroll") for (int n = 0; n < 2; ++n) \
        asm volatile("v_mfma_scale_f32_16x16x128_f8f6f4 %0, %1, %2, %0, %3, %4 op_sel_hi:[0,0,0]" : "+v"(acc[ai][bj][m][n]) : "v"(Bt##8[n]), "v"(At##8[m]), "v"(wsc_), "v"(asc_)); } \
      else { _Pragma("unroll") for (int m = 0; m < 4; ++m) _Pragma("unroll") for (int n = 0; n < 2; ++n) _Pragma("unroll") for (int k = 0; k < 2; ++k) \
        acc[ai][bj][m][n] = __builtin_amdgcn_mfma_f32_16x16x32_bf16(Bt[n][k], At[m][k], acc[ai][bj][m][n], 0, 0, 0); } __builtin_amdgcn_s_setprio(0); } while (0)
#define PG8_WAIT_V(n) asm volatile("s_waitcnt vmcnt(" #n ")" ::: "memory")
#define PG8_WAIT_L(n) asm volatile("s_waitcnt lgkmcnt(" #n ")" ::: "memory")
#define PG8_BAR __builtin_amdgcn_s_barrier()
#define PG8_SCHED __builtin_amdgcn_sched_barrier(0)
    Unit cur, nxt; int ui = 0;
    if (!S.next(0, cur)) return;
    f32x4 acc[2][2][4][2];
#pragma unroll
    for (int a = 0; a < 2; ++a)
#pragma unroll
        for (int b = 0; b < 2; ++b)
#pragma unroll
            for (int m = 0; m < 4; ++m)
#pragma unroll
                for (int n = 0; n < 2; ++n) acc[a][b][m][n] = (f32x4){0.f, 0.f, 0.f, 0.f};
    bf16x8 At[4][2], B0[2][2], B1[2][2]; v8i_t At8[4], B08[2], B18[2]; int wsc_ = WSC, asc_ = ASC; (void)wsc_; (void)asc_;
    const char* cA = cur.a; const char* cB = cur.b;
    PG8_STAGE(PG8_SB(0, 0), cB, voffB); PG8_STAGE(PG8_SB(0, 1), cB + hstepB, voffB); PG8_STAGE(PG8_SA(0, 0), cA, voffA); PG8_STAGE(PG8_SA(0, 1), cA + hstepA, voffA);
    if (wr == 1) PG8_BAR;
    PG8_WAIT_V(2); PG8_BAR;
    PG8_STAGE(PG8_SB(1, 0), cB + kstep, voffB); PG8_STAGE(PG8_SA(1, 0), cA + kstep, voffA); PG8_STAGE(PG8_SB(1, 1), cB + hstepB + kstep, voffB);
    PG8_WAIT_V(6); PG8_BAR;
#pragma unroll 1
    for (;;) {
        const bool has_next = S.next(ui + 1, nxt);
        const char* nA = has_next ? nxt.a : cA; const char* nB = has_next ? nxt.b : cB;
#pragma unroll 1
        for (int t = 0; t < nt; t += 2) {
            const bool last = (t == nt - 2);
            const char* a1 = cA + (size_t)(t + 1) * kstep;
            const char* a2 = last ? nA : cA + (size_t)(t + 2) * kstep; const char* b2 = last ? nB : cB + (size_t)(t + 2) * kstep;
            const char* a3 = a2 + kstep; const char* b3 = b2 + kstep;
            PG8_LDB(B0, 0, 0); PG8_LDB(B1, 0, 1); PG8_SCHED; PG8_LDA(At, 0, 0); PG8_STAGE(PG8_SA(1, 1), a1 + hstepA, voffA);
            PG8_WAIT_V(8); PG8_WAIT_L(0); PG8_BAR; PG8_MMA(0, 0, At, B0); PG8_MMA(0, 1, At, B1); PG8_BAR; PG8_SCHED;
            PG8_LDA(At, 0, 1); PG8_STAGE(PG8_SB(0, 0), b2, voffB); PG8_STAGE(PG8_SB(0, 1), b2 + hstepB, voffB); PG8_STAGE(PG8_SA(0, 0), a2, voffA);
            PG8_WAIT_V(8); PG8_WAIT_L(0); PG8_BAR; PG8_MMA(1, 0, At, B0); PG8_MMA(1, 1, At, B1); PG8_BAR; PG8_SCHED;
            PG8_LDB(B0, 1, 0); PG8_LDB(B1, 1, 1); PG8_SCHED; PG8_LDA(At, 1, 0); PG8_STAGE(PG8_SA(0, 1), a2 + hstepA, voffA);
            PG8_WAIT_V(8); PG8_WAIT_L(0); PG8_BAR; PG8_MMA(0, 0, At, B0); PG8_MMA(0, 1, At, B1); PG8_BAR; PG8_SCHED;
            PG8_LDA(At, 1, 1); PG8_STAGE(PG8_SB(1, 0), b3, voffB); PG8_STAGE(PG8_SB(1, 1), b3 + hstepB, voffB); PG8_STAGE(PG8_SA(1, 0), a3, voffA);
            PG8_WAIT_V(8); PG8_WAIT_L(0); PG8_BAR; PG8_MMA(1, 0, At, B0); PG8_MMA(1, 1, At, B1); PG8_BAR; PG8_SCHED;
        }
        if (wr == 0) PG8_BAR;
        if constexpr (FP8) asm volatile("s_nop 15\n\ts_nop 15" ::: "memory");
        E(acc, cur, wr, wc, fr, fq);
        if (!has_next) break;
#pragma unroll
        for (int a = 0; a < 2; ++a)
#pragma unroll
            for (int b = 0; b < 2; ++b)
#pragma unroll
                for (int m = 0; m < 4; ++m)
#pragma unroll
                    for (int n = 0; n < 2; ++n) acc[a][b][m][n] = (f32x4){0.f, 0.f, 0.f, 0.f};
        cur = nxt; cA = nA; cB = nB; ++ui;
        if (wr == 1) PG8_BAR;
    }
    PG8_WAIT_V(0);
    PG8_BAR;
#undef PG8_SA
#undef PG8_SB
#undef PG8_STAGE
#undef PG8_LDA
#undef PG8_LD16
#undef PG8_LDB
#undef PG8_MMA
#undef PG8_WAIT_V
#undef PG8_WAIT_L
#undef PG8_BAR
#undef PG8_SCHED
}
template <class Epi, class Sched>
__device__ __forceinline__ void gemm_phase(LAS unsigned char* lds, const int K, const int lda, const int ldb, const Sched& S, const Epi& E) {
    gemm_phase_t<false, 0, 0>(lds, K / BK, lda * 2, ldb * 2, S, E);
}

template <int ACT> struct EpiBf16 {
    static constexpr bool PERM = true;
    bf16_t* O0; bf16_t* O1; bf16_t* O2; int ld0, ld12; int q8;
    __device__ __forceinline__ void operator()(const f32x4 (&acc)[2][2][4][2], const Unit& u, int wr, int wc, int fr, int fq) const {
        bf16_t* base = u.sel == 0 ? O0 : (u.sel == 1 ? O1 : O2); const int ldc = u.sel == 0 ? ld0 : ld12;
        const bool f8 = q8 && u.sel == 0;
        const int row0 = u.orow + wr * 64 + fr, col0 = u.ocol + wc * 32 + 8 * fq;
#pragma unroll
        for (int ai = 0; ai < 2; ++ai)
#pragma unroll
            for (int m = 0; m < 4; ++m) { bf16_t* rowp = base + (size_t)(row0 + ai * HALF + m * 16) * ldc + col0;
#pragma unroll
                for (int bj = 0; bj < 2; ++bj) { f32x4 v0 = acc[ai][bj][m][0], v1 = acc[ai][bj][m][1];
                    if (ACT == 1) {
#pragma unroll
                        for (int e = 0; e < 4; ++e) { float a = fmaxf(v0[e], 0.f), b = fmaxf(v1[e], 0.f); v0[e] = a * a; v1[e] = b * b; } }
                    u32x4 w; w.x = cvt_pk_bf16(v0[0], v0[1]); w.y = cvt_pk_bf16(v0[2], v0[3]); w.z = cvt_pk_bf16(v1[0], v1[1]); w.w = cvt_pk_bf16(v1[2], v1[3]);
                    if (f8) { u32x2 w8; w8.x = pk4_fp8g(v0[0], v0[1], v0[2], v0[3]); w8.y = pk4_fp8g(v1[0], v1[1], v1[2], v1[3]);
                        *(u32x2*)((unsigned char*)O0 + (size_t)(row0 + ai * HALF + m * 16) * ld0 + col0 + bj * HALF) = w8; }
                    else *(u32x4*)(rowp + bj * HALF) = w; } }
    }
};
template <bool BF> struct EpiResid {
    static constexpr bool PERM = true;
    const float* basef; bf16_t* xb; const float* gate;
    __device__ __forceinline__ void operator()(const f32x4 (&acc)[2][2][4][2], const Unit& u, int wr, int wc, int fr, int fq) const {
        const int col0 = u.ocol + wc * 32 + 8 * fq; const float* gp = gate + (size_t)(u.orow / SEQ) * NMOD + col0;
        f32x4 gv[2][2];
#pragma unroll
        for (int bj = 0; bj < 2; ++bj)
#pragma unroll
            for (int n = 0; n < 2; ++n) gv[bj][n] = *(const f32x4*)(gp + bj * HALF + 4 * n);
        if constexpr (BF) {
            u32x4 w[2][4][2];
#pragma unroll
            for (int ai = 0; ai < 2; ++ai)
#pragma unroll
                for (int m = 0; m < 4; ++m)
#pragma unroll
                    for (int bj = 0; bj < 2; ++bj) w[ai][m][bj] = *(const u32x4*)(xb + (size_t)(u.orow + ai * HALF + wr * 64 + m * 16 + fr) * DM + col0 + bj * HALF);
            asm volatile("" ::: "memory");
#pragma unroll
            for (int ai = 0; ai < 2; ++ai)
#pragma unroll
                for (int m = 0; m < 4; ++m)
#pragma unroll
                    for (int bj = 0; bj < 2; ++bj) { const u32x4 x = w[ai][m][bj];
                        const f32x4 o0 = (f32x4){bf_lo(x.x), bf_hi(x.x), bf_lo(x.y), bf_hi(x.y)} + gv[bj][0] * acc[ai][bj][m][0], o1 = (f32x4){bf_lo(x.z), bf_hi(x.z), bf_lo(x.w), bf_hi(x.w)} + gv[bj][1] * acc[ai][bj][m][1];
                        u32x4 y; y.x = cvt_pk_bf16(o0[0], o0[1]); y.y = cvt_pk_bf16(o0[2], o0[3]); y.z = cvt_pk_bf16(o1[0], o1[1]); y.w = cvt_pk_bf16(o1[2], o1[3]);
                        *(u32x4*)(xb + (size_t)(u.orow + ai * HALF + wr * 64 + m * 16 + fr) * DM + col0 + bj * HALF) = y; }
        }
#pragma unroll
        for (int ai = 0; ai < 2; ++ai) {
            if constexpr (BF) {
            } else {
#pragma unroll
                for (int mh = 0; mh < 2; ++mh) {
                    f32x4 b[2][2][2];
#pragma unroll
                    for (int mm = 0; mm < 2; ++mm)
#pragma unroll
                        for (int bj = 0; bj < 2; ++bj) { const float* bp = basef + (size_t)(u.orow + ai * HALF + wr * 64 + (2 * mh + mm) * 16 + fr) * DM + col0 + bj * HALF; b[mm][bj][0] = *(const f32x4*)bp; b[mm][bj][1] = *(const f32x4*)(bp + 4); }
                    asm volatile("" ::: "memory");
#pragma unroll
                    for (int mm = 0; mm < 2; ++mm)
#pragma unroll
                        for (int bj = 0; bj < 2; ++bj) { const int m = 2 * mh + mm; const f32x4 o0 = b[mm][bj][0] + gv[bj][0] * acc[ai][bj][m][0], o1 = b[mm][bj][1] + gv[bj][1] * acc[ai][bj][m][1];
                            u32x4 y; y.x = cvt_pk_bf16(o0[0], o0[1]); y.y = cvt_pk_bf16(o0[2], o0[3]); y.z = cvt_pk_bf16(o1[0], o1[1]); y.w = cvt_pk_bf16(o1[2], o1[3]);
                            *(u32x4*)(xb + (size_t)(u.orow + ai * HALF + wr * 64 + m * 16 + fr) * DM + col0 + bj * HALF) = y; }
                }
            }
        }
    }
};
struct EpiSeq2 {
    static constexpr bool PERM = true;
    bf16_t* Y; bf16_t* Pt; const float* zfix;
    __device__ __forceinline__ void operator()(const f32x4 (&acc)[2][2][4][2], const Unit& u, int wr, int wc, int fr, int fq) const {
        const int row0 = wr * 64 + fr, col0 = u.ocol + wc * 32 + 8 * fq;
        if (u.sel == 0) {
#pragma unroll
            for (int ai = 0; ai < 2; ++ai)
#pragma unroll
                for (int m = 0; m < 4; ++m) { bf16_t* rp = Pt + (size_t)(u.orow + row0 + ai * HALF + m * 16) * DM + col0;
#pragma unroll
                    for (int bj = 0; bj < 2; ++bj) { const f32x4 v0 = acc[ai][bj][m][0], v1 = acc[ai][bj][m][1];
                        u32x4 w; w.x = cvt_pk_bf16(v0[0], v0[1]); w.y = cvt_pk_bf16(v0[2], v0[3]); w.z = cvt_pk_bf16(v1[0], v1[1]); w.w = cvt_pk_bf16(v1[2], v1[3]);
                        *(u32x4*)(rp + bj * HALF) = w; } }
        } else {
            const int b = u.aux >> 16, k0 = u.aux & 0xffff;
            const float sg = (fr & 1) ? -(1.f / 64.f) : (1.f / 64.f);
            const float* zp = zfix + b * DM + col0;
            f32x4 z[2][2];
#pragma unroll
            for (int bj = 0; bj < 2; ++bj)
#pragma unroll
                for (int n = 0; n < 2; ++n) z[bj][n] = *(const f32x4*)(zp + bj * HALF + 4 * n) * sg;
#pragma unroll
            for (int ai = 0; ai < 2; ++ai) {
                u32x4 pw[4][2];
#pragma unroll
                for (int m = 0; m < 4; ++m)
#pragma unroll
                    for (int bj = 0; bj < 2; ++bj) pw[m][bj] = *(const u32x4*)(Pt + (size_t)(u.orow + row0 + ai * HALF + m * 16) * DM + col0 + bj * HALF);
                asm volatile("" ::: "memory");
#pragma unroll
                for (int m = 0; m < 4; ++m) { const int r = row0 + ai * HALF + m * 16, k = k0 + r;
                    bf16_t* y1 = Y + ((size_t)b * SEQ + k) * DM + col0; bf16_t* y2 = Y + ((size_t)b * SEQ + (SEQ - k)) * DM + col0;
#pragma unroll
                    for (int bj = 0; bj < 2; ++bj) { const u32x4 x = pw[m][bj];
                        const f32x4 p0 = (f32x4){bf_lo(x.x), bf_hi(x.x), bf_lo(x.y), bf_hi(x.y)} + z[bj][0], p1 = (f32x4){bf_lo(x.z), bf_hi(x.z), bf_lo(x.w), bf_hi(x.w)} + z[bj][1];
                        const f32x4 q0 = acc[ai][bj][m][0], q1 = acc[ai][bj][m][1];
                        { const f32x4 v0 = p0 - q0, v1 = p1 - q1; u32x4 w; w.x = cvt_pk_bf16(v0[0], v0[1]); w.y = cvt_pk_bf16(v0[2], v0[3]); w.z = cvt_pk_bf16(v1[0], v1[1]); w.w = cvt_pk_bf16(v1[2], v1[3]); *(u32x4*)(y1 + bj * HALF) = w; }
                        if (k > 0) { const f32x4 v0 = p0 + q0, v1 = p1 + q1; u32x4 w; w.x = cvt_pk_bf16(v0[0], v0[1]); w.y = cvt_pk_bf16(v0[2], v0[3]); w.z = cvt_pk_bf16(v1[0], v1[1]); w.w = cvt_pk_bf16(v1[2], v1[3]); *(u32x4*)(y2 + bj * HALF) = w; } } }
            }
        }
    }
};

struct SchedStd {
    const char* A; const char* B; int nM, nN, G, c; size_t astep, bstep; int wgm;
    __device__ __forceinline__ bool next(int i, Unit& u) const {
        const int L = i * G + c; if (L >= nM * nN) return false;
        int pm, pn; tile_map(L, nM, nN, pm, pn, wgm ? wgm : 8);
        u.a = A + (size_t)pm * astep; u.b = B + (size_t)pn * bstep; u.orow = pm * BM; u.ocol = pn * BM; u.sel = 0; return true;
    }
};
struct SchedQKV {
    const char* A; const char* B; int G, c;
    __device__ __forceinline__ bool next(int i, Unit& u) const {
        const int L = i * G + c; if (L >= 784) return false;
        int pm, pn; if (L < 768) tile_map(L, 64, 12, pm, pn); else { pm = 64 + (L - 768) / 4; pn = 8 + (L - 768) % 4; }
        u.a = A + (size_t)pm * (BM * DM); u.b = B + (size_t)pn * (BM * DM);
        if (pn < 8) { u.sel = 0; u.orow = pm * BM; u.ocol = pn * BM; }
        else { const int krow = pm < 64 ? pm * BM + CTXL * (pm / 16) : (pm - 64) * SKV + SEQ;
               u.orow = krow; if (pn < 10) { u.sel = 1; u.ocol = (pn - 8) * BM; } else { u.sel = 2; u.ocol = (pn - 10) * BM; } }
        return true;
    }
};
struct SchedChan {
    const char* C; const char* Sm; const char* U; int G, c;
    __device__ __forceinline__ bool next(int i, Unit& u) const {
        const int L = i * G + c; if (L >= 512) return false;
        const int g = L & 7, b = (L >> 3) & 3, jt = L >> 5;
        u.a = jt < 8 ? C : Sm; u.b = U + ((size_t)(b * SEQ + jt * BM) * DM + g * 256) * 2;
        u.orow = (b * 8 + g) * BM; u.ocol = jt * BM; u.sel = 0; return true;
    }
};
struct SchedSeq2 {
    const char* T; const char* ZT; int G, c;
    __device__ __forceinline__ bool next(int i, Unit& u) const {
        const int tile = (i >> 1) * G + c, kind = i & 1; if (tile >= 256) return false;
        int pm, pn; tile_map(tile, 8, 32, pm, pn);
        u.a = T + (size_t)kind * (8u << 20) + (size_t)pm * (BM * 2048 * 2); u.b = ZT + (size_t)pn * (BM * 4096 * 2) + (size_t)kind * (2048 * 2);
        u.orow = (pn >> 3) * 2048 + pm * BM; u.ocol = (pn & 7) * BM; u.sel = kind; u.aux = ((pn >> 3) << 16) | (pm * BM); return true;
    }
};
}

namespace att {
constexpr int D = 128, NW = 8, QBLK = 32, KVBLK = 64;
constexpr float SCALE = 0.088388347648318440f;
constexpr float THR = 8.f;
constexpr int LDQ = DM, LDK = KVD, LDO = DM;
constexpr size_t SHM_V = KVBLK * D * 2, SHM_K = KVBLK * D * 2, SHM_ATTN = 2 * SHM_V + 2 * SHM_K + NW * 64 * 4;
#define KSWZ(row, colB) ((row) * 256 + ((colB) ^ (((row) & 7) << 4)))
#define SBAR() __builtin_amdgcn_sched_barrier(0)
__device__ __forceinline__ int crow(int r, int hi) { return (r & 3) + 8 * (r >> 2) + 4 * hi; }
__device__ __forceinline__ unsigned cvtpk(float lo, float hi) { unsigned r; asm volatile("v_cvt_pk_bf16_f32 %0, %1, %2" : "=v"(r) : "v"(lo), "v"(hi)); return r; }

__device__ __forceinline__ void partialSM(f32x16& p0, f32x16& p1, float& m_reg, float& mn, float& alpha) {
  constexpr float C = SCALE * 1.4426950408889634f;
  float pmax = p0[0]; for (int r = 1; r < 16; ++r) pmax = fmaxf(pmax, p0[r]); for (int r = 0; r < 16; ++r) pmax = fmaxf(pmax, p1[r]);
  { auto rr = __builtin_amdgcn_permlane32_swap(__float_as_uint(pmax), __float_as_uint(pmax), false, false);
    pmax = fmaxf(__uint_as_float(rr[0]), __uint_as_float(rr[1])); }
  if (__builtin_expect(__all(pmax - m_reg <= THR / SCALE), 1)) { mn = m_reg; alpha = 1.f; }
  else { mn = fmaxf(m_reg, pmax); alpha = __builtin_amdgcn_exp2f((m_reg - mn) * C); m_reg = mn; }
  float mnC = -mn * C;
  for (int r = 0; r < 16; ++r) p0[r] = fmaf(p0[r], C, mnC); for (int r = 0; r < 16; ++r) p1[r] = fmaf(p1[r], C, mnC);
  for (int r = 0; r < 16; ++r) p0[r] = __builtin_amdgcn_exp2f(p0[r]);
}
__device__ __forceinline__ void finishSM(f32x16& p0, f32x16& p1, float alpha, float& l_reg, bf16x8& pa0, bf16x8& pa1, bf16x8& pa2, bf16x8& pa3) {
  for (int r = 0; r < 16; ++r) p1[r] = __builtin_amdgcn_exp2f(p1[r]);
  float ps = 0; for (int r = 0; r < 16; ++r) ps += p0[r]; for (int r = 0; r < 16; ++r) ps += p1[r];
  { auto rr = __builtin_amdgcn_permlane32_swap(__float_as_uint(ps), __float_as_uint(ps), false, false);
    ps = __uint_as_float(rr[0]) + __uint_as_float(rr[1]); }
  l_reg = l_reg * alpha + ps;
#define PK4(P, BASE, OUT) do { unsigned a0 = cvtpk(P[BASE + 0], P[BASE + 1]), a1 = cvtpk(P[BASE + 2], P[BASE + 3]);   \
    unsigned b0 = cvtpk(P[BASE + 4], P[BASE + 5]), b1 = cvtpk(P[BASE + 6], P[BASE + 7]);                              \
    auto r0 = __builtin_amdgcn_permlane32_swap(a0, b0, false, false); auto r1 = __builtin_amdgcn_permlane32_swap(a1, b1, false, false); \
    u32x4 w = {r0[0], r1[0], r0[1], r1[1]}; OUT = *reinterpret_cast<bf16x8*>(&w); } while (0)
  PK4(p0, 0, pa0); PK4(p0, 8, pa1); PK4(p1, 0, pa2); PK4(p1, 8, pa3);
#undef PK4
}
__device__ __forceinline__ void qkt(f32x16& p0, f32x16& p1, const bf16_t* Ks, const bf16x8* qr, int r32, int hi) {
  p0 = f32x16{}; p1 = f32x16{};
  for (int d0 = 0; d0 < 8; ++d0) { int cb = (d0 * 16 + hi * 8) * 2;
    bf16x8 b0 = *reinterpret_cast<const bf16x8*>((const char*)Ks + KSWZ(r32, cb));
    bf16x8 b1 = *reinterpret_cast<const bf16x8*>((const char*)Ks + KSWZ(32 + r32, cb));
    p0 = __builtin_amdgcn_mfma_f32_32x32x16_bf16(b0, qr[d0], p0, 0, 0, 0);
    p1 = __builtin_amdgcn_mfma_f32_32x32x16_bf16(b1, qr[d0], p1, 0, 0, 0); }
}
__device__ __forceinline__ int v_st(int k, int c) { const int kk = (k & ~0xC) | ((k & 4) << 1) | ((k & 8) >> 1); return ((kk >> 3) * 4 + (c >> 5)) * 512 + ((kk & 7) * 32 + (c & 31)) * 2; }
__device__ __forceinline__ int v_rd_base(int lane) { return ((lane & 3) << 3) | (((lane >> 2) & 3) << 6) | (((lane >> 4) & 1) << 5) | (((lane >> 5) & 1) << 8); }
constexpr int v_rd_off(int d0, int ks, int half) { return d0 * 512 + ks * 4096 + half * 2048; }
template <int OFF> __device__ __forceinline__ s16x4 tr_read(int vb) {
  s16x4 r; asm volatile("ds_read_b64_tr_b16 %0, %1 offset:%2" : "=&v"(r) : "v"(vb), "i"(OFF) : "memory"); return r;
}
template <int D0> __device__ __forceinline__ void pv_one(f32x16& od, int vb, bf16x8 pa0, bf16x8 pa1, bf16x8 pa2, bf16x8 pa3) {
  const s16x4 l0 = tr_read<v_rd_off(D0, 0, 0)>(vb), h0 = tr_read<v_rd_off(D0, 0, 1)>(vb), l1 = tr_read<v_rd_off(D0, 1, 0)>(vb), h1 = tr_read<v_rd_off(D0, 1, 1)>(vb);
  const s16x4 l2 = tr_read<v_rd_off(D0, 2, 0)>(vb), h2 = tr_read<v_rd_off(D0, 2, 1)>(vb), l3 = tr_read<v_rd_off(D0, 3, 0)>(vb), h3 = tr_read<v_rd_off(D0, 3, 1)>(vb);
  asm volatile("s_waitcnt lgkmcnt(0)" ::: "memory"); SBAR();
#define PK(L, H) (bf16x8){L[0], L[1], L[2], L[3], H[0], H[1], H[2], H[3]}
  od = __builtin_amdgcn_mfma_f32_32x32x16_bf16(pa0, PK(l0, h0), od, 0, 0, 0);
  od = __builtin_amdgcn_mfma_f32_32x32x16_bf16(pa1, PK(l1, h1), od, 0, 0, 0);
  od = __builtin_amdgcn_mfma_f32_32x32x16_bf16(pa2, PK(l2, h2), od, 0, 0, 0);
  od = __builtin_amdgcn_mfma_f32_32x32x16_bf16(pa3, PK(l3, h3), od, 0, 0, 0);
#undef PK
}
__device__ __forceinline__ void pv_d0(f32x16* o, int vb, bf16x8 pa0, bf16x8 pa1, bf16x8 pa2, bf16x8 pa3) {
  pv_one<0>(o[0], vb, pa0, pa1, pa2, pa3); pv_one<1>(o[1], vb, pa0, pa1, pa2, pa3); pv_one<2>(o[2], vb, pa0, pa1, pa2, pa3); pv_one<3>(o[3], vb, pa0, pa1, pa2, pa3);
}

__device__ __forceinline__ void attn_dense_body(const bf16_t* __restrict__ Qb, const bf16_t* __restrict__ Kh, const bf16_t* __restrict__ Vh,
                                                bf16_t* __restrict__ Ob, int seq, int s0, const float* __restrict__ qg,
                                                const float* __restrict__ ropec, const float* __restrict__ ropes, char* lds) {
  int tid_o = threadIdx.x; asm volatile("" : "+v"(tid_o));
  const int tid = tid_o, wid = tid >> 6, lane = tid & 63, r32 = lane & 31, hi = lane >> 5;
  bf16_t* V_lds = (bf16_t*)lds; bf16_t* K_lds = (bf16_t*)(lds + 2 * SHM_V);
  float* ws = (float*)(lds + 2 * SHM_V + 2 * SHM_K) + wid * 64; float* li_l = ws; float* al_l = ws + 32;
  float m_reg = -1e30f, l_reg = 0; f32x16 o[4] = {}; bf16x8 qr[8];
  {
    const bf16_t* Qw = Qb + (long)(wid * QBLK + r32) * LDQ + hi * 8;
    u32x4 raw[8];
#pragma unroll
    for (int d0 = 0; d0 < 8; ++d0) raw[d0] = *reinterpret_cast<const u32x4*>(Qw + d0 * 16);
    float ss = 0.f;
#pragma unroll
    for (int d0 = 0; d0 < 8; ++d0)
#pragma unroll
      for (int e = 0; e < 4; ++e) { const float a = bf_lo(raw[d0][e]), b = bf_hi(raw[d0][e]); ss += a * a + b * b; }
    { auto rr = __builtin_amdgcn_permlane32_swap(__float_as_uint(ss), __float_as_uint(ss), false, false); ss = __uint_as_float(rr[0]) + __uint_as_float(rr[1]); }
    const float rstd = 1.0f / sqrtf(ss * (1.f / 128.f) + EPS);
    const int s = s0 + wid * QBLK + r32, prow = s >> 6, pcol = s & 63;
#pragma unroll
    for (int d0 = 0; d0 < 8; ++d0) {
      const int pos = d0 < 4 ? prow : pcol, f0 = (8 * d0 + 4 * hi) & 31;
      const f32x4 c4 = *reinterpret_cast<const f32x4*>(ropec + pos * 32 + f0), s4 = *reinterpret_cast<const f32x4*>(ropes + pos * 32 + f0);
      const f32x4 g0 = *reinterpret_cast<const f32x4*>(qg + d0 * 16 + hi * 8), g1 = *reinterpret_cast<const f32x4*>(qg + d0 * 16 + hi * 8 + 4);
      u32x4 w;
#pragma unroll
      for (int e = 0; e < 4; ++e) { const float gl = e < 2 ? g0[2 * e] : g1[2 * e - 4], gh = e < 2 ? g0[2 * e + 1] : g1[2 * e - 3];
        const float y0 = bf_lo(raw[d0][e]) * rstd * gl, y1 = bf_hi(raw[d0][e]) * rstd * gh;
        w[e] = cvtpk(y0 * c4[e] - y1 * s4[e], y0 * s4[e] + y1 * c4[e]); }
      qr[d0] = *reinterpret_cast<bf16x8*>(&w);
    }
  }
  const int sr = tid >> 4, sc = (tid & 15) * 8, vst0 = v_st(sr, sc), vst1 = v_st(32 + sr, sc);
  const int vb0 = (int)(uintptr_t)V_lds + v_rd_base(lane);
  struct { bf16x8 vs0, vs1, ks0, ks1; } sr_[2];
#define LD8(p) (*reinterpret_cast<const bf16x8*>(p))
#define SLOAD(i, k0) do { sr_[i].vs0 = LD8(&Vh[(long)((k0) + sr) * LDK + sc]); sr_[i].vs1 = LD8(&Vh[(long)((k0) + 32 + sr) * LDK + sc]); \
    sr_[i].ks0 = LD8(&Kh[(long)((k0) + sr) * LDK + sc]); sr_[i].ks1 = LD8(&Kh[(long)((k0) + 32 + sr) * LDK + sc]); } while (0)
#define SWRITE(b, i) do { *(bf16x8*)((char*)V_lds + (b) * SHM_V + vst0) = sr_[i].vs0;          \
    *(bf16x8*)((char*)V_lds + (b) * SHM_V + vst1) = sr_[i].vs1; int kc = sc * 2;               \
    *(bf16x8*)((char*)K_lds + (b) * SHM_K + KSWZ(sr, kc)) = sr_[i].ks0;                       \
    *(bf16x8*)((char*)K_lds + (b) * SHM_K + KSWZ(32 + sr, kc)) = sr_[i].ks1; } while (0)
#define SWAIT() asm volatile("s_waitcnt vmcnt(4)" ::: "memory")
#define RESC(a) do { if (__any((a) < 1.f)) { if (hi == 0) al_l[r32] = (a); asm volatile("s_waitcnt lgkmcnt(0)" ::: "memory"); \
    for (int d = 0; d < 4; ++d) for (int r = 0; r < 16; ++r) o[d][r] *= al_l[crow(r, hi)]; } } while (0)
  f32x16 pA0, pA1, pB0, pB1; float mnA, mnB, alA, alB; bf16x8 pa0, pa1, pa2, pa3; const int NT = seq / KVBLK;
  constexpr int SE = 0, SO = 1;
  SLOAD(SE, 0); asm volatile("s_waitcnt vmcnt(0)" ::: "memory"); SWRITE(0, SE); __syncthreads();
  qkt(pA0, pA1, K_lds, qr, r32, hi); partialSM(pA0, pA1, m_reg, mnA, alA);
  SLOAD(SO, KVBLK); if (2 < NT) SLOAD(SE, 2 * KVBLK);
  SWAIT(); SWRITE(1, SO); __syncthreads();
  for (int j = 1; j + 1 < NT; j += 2) {
    SBAR(); qkt(pB0, pB1, (bf16_t*)((char*)K_lds + SHM_K), qr, r32, hi);
    finishSM(pA0, pA1, alA, l_reg, pa0, pa1, pa2, pa3); SBAR();
    SLOAD(SO, (j + 2) * KVBLK); SBAR();
    pv_d0(o, vb0, pa0, pa1, pa2, pa3); partialSM(pB0, pB1, m_reg, mnB, alB);
    __syncthreads(); SWAIT(); SWRITE(0, SE);
    RESC(alB); __syncthreads();
    SBAR(); qkt(pA0, pA1, K_lds, qr, r32, hi);
    finishSM(pB0, pB1, alB, l_reg, pa0, pa1, pa2, pa3); SBAR();
    if (j + 3 < NT) SLOAD(SE, (j + 3) * KVBLK); SBAR();
    pv_d0(o, vb0 + (int)SHM_V, pa0, pa1, pa2, pa3); partialSM(pA0, pA1, m_reg, mnA, alA);
    __syncthreads(); SWAIT(); SWRITE(1, SO);
    RESC(alA); __syncthreads();
  }
  SBAR(); qkt(pB0, pB1, (bf16_t*)((char*)K_lds + SHM_K), qr, r32, hi);
  finishSM(pA0, pA1, alA, l_reg, pa0, pa1, pa2, pa3); SBAR();
  pv_d0(o, vb0, pa0, pa1, pa2, pa3); partialSM(pB0, pB1, m_reg, mnB, alB);
  __syncthreads(); RESC(alB);
  finishSM(pB0, pB1, alB, l_reg, pa0, pa1, pa2, pa3); SBAR();
  pv_d0(o, vb0 + (int)SHM_V, pa0, pa1, pa2, pa3);
  if (hi == 0) li_l[r32] = l_reg; asm volatile("s_waitcnt lgkmcnt(0)" ::: "memory");
  float rli[16];
#pragma unroll
  for (int r = 0; r < 16; ++r) rli[r] = __builtin_amdgcn_rcpf(li_l[crow(r, hi)]);
  bf16_t* Ow = Ob + (long)(wid * QBLK) * LDO;
#pragma unroll
  for (int r = 0; r < 16; ++r) { int orow = crow(r, hi);
    for (int d0 = 0; d0 < 4; ++d0) Ow[(long)orow * LDO + d0 * 32 + r32] = (bf16_t)f2bf(o[d0][r] * rli[r]); }
  __syncthreads();
#undef LD8
#undef SLOAD
#undef SWRITE
#undef SWAIT
#undef RESC
}
#undef KSWZ
#undef SBAR
}


namespace att8 {
typedef int v8i __attribute__((ext_vector_type(8)));
constexpr int NW = 8, QBLK = 32, KVBLK = 64, TILEB = 8192;
constexpr float SCALE = 0.088388347648318440f;
constexpr float THR = 3.5f;
constexpr float PBIAS = 3.0f;
constexpr int NSLOT = 6, LDS_K = 0, LDS_V = NSLOT * TILEB, LDS_WS = 2 * NSLOT * TILEB;
#define SBAR() __builtin_amdgcn_sched_barrier(0)
__device__ __forceinline__ int crow(int r, int hi) { return (r & 3) + 8 * (r >> 2) + 4 * hi; }
__device__ __forceinline__ f32x16 mfma8(v8i a, v8i b, f32x16 c) { return __builtin_amdgcn_mfma_scale_f32_32x32x64_f8f6f4(a, b, c, 0, 0, 0, 0x7f7f7f7f, 0, 0x7f7f7f7f); }
__device__ __forceinline__ unsigned pk4_fp8(float a, float b, float c, float d) { unsigned w;
  asm("v_cvt_pk_fp8_f32 %0, %1, %2" : "=v"(w) : "v"(a), "v"(b)); asm("v_cvt_pk_fp8_f32 %0, %1, %2 op_sel:[0,0,1]" : "+v"(w) : "v"(c), "v"(d)); return w; }
__device__ __forceinline__ v8i ld32(const LAS unsigned char* p0, const LAS unsigned char* p1) {
  const u32x4 a = *(const LAS u32x4*)p0, b = *(const LAS u32x4*)p1; v8i r; r[0] = a.x; r[1] = a.y; r[2] = a.z; r[3] = a.w; r[4] = b.x; r[5] = b.y; r[6] = b.z; r[7] = b.w; return r; }

template <bool FIRST> __device__ __forceinline__ void partialSM(f32x16& p0, f32x16& p1, float& mhat, f32x16& negm, float& alpha) {
  constexpr float THRL = THR * 1.4426950408889634f;
  float pmax = p0[0]; for (int r = 1; r < 16; ++r) pmax = fmaxf(pmax, p0[r]); for (int r = 0; r < 16; ++r) pmax = fmaxf(pmax, p1[r]);
  { auto rr = __builtin_amdgcn_permlane32_swap(__float_as_uint(pmax), __float_as_uint(pmax), false, false);
    pmax = fmaxf(__uint_as_float(rr[0]), __uint_as_float(rr[1])); }
  const float rm = pmax - PBIAS;
  alpha = 1.f;
  if (FIRST || !__builtin_expect(__all(rm <= THRL), 1)) {
    const float dl = FIRST ? rm : fmaxf(rm, 0.f); mhat += dl;
    for (int r = 0; r < 16; ++r) { p0[r] -= dl; p1[r] -= dl; }
    const float nm = PBIAS - mhat; for (int r = 0; r < 16; ++r) negm[r] = nm;
    if (!FIRST) alpha = __builtin_amdgcn_exp2f(-dl);
  }
  for (int r = 0; r < 16; ++r) p0[r] = __builtin_amdgcn_exp2f(p0[r]);
}
__device__ __forceinline__ void finishSM(f32x16& p0, f32x16& p1, float alpha, float& l_reg, v8i& pa) {
  for (int r = 0; r < 16; ++r) p1[r] = __builtin_amdgcn_exp2f(p1[r]);
  float ps = 0; for (int r = 0; r < 16; ++r) ps += p0[r]; for (int r = 0; r < 16; ++r) ps += p1[r];
  { auto rr = __builtin_amdgcn_permlane32_swap(__float_as_uint(ps), __float_as_uint(ps), false, false);
    ps = __uint_as_float(rr[0]) + __uint_as_float(rr[1]); }
  l_reg = l_reg * alpha + ps;
#pragma unroll
  for (int w = 0; w < 4; ++w) { pa[w] = (int)pk4_fp8(p0[4 * w], p0[4 * w + 1], p0[4 * w + 2], p0[4 * w + 3]); pa[4 + w] = (int)pk4_fp8(p1[4 * w], p1[4 * w + 1], p1[4 * w + 2], p1[4 * w + 3]); }
}
__device__ __forceinline__ void qkt(f32x16& p0, f32x16& p1, const LAS unsigned char* Ks, const v8i* qr, const f32x16& negm, int r32, int hi) {
  const int sw = (r32 >> 1) & 7;
  const LAS unsigned char* ra = Ks + r32 * 128; const LAS unsigned char* rb = Ks + (32 + r32) * 128;
#pragma unroll
  for (int m = 0; m < 2; ++m) { const int c0 = 4 * m + 2 * hi;
    const v8i a0 = ld32(ra + 16 * (c0 ^ sw), ra + 16 * ((c0 + 1) ^ sw)), a1 = ld32(rb + 16 * (c0 ^ sw), rb + 16 * ((c0 + 1) ^ sw));
    if (m == 0) { p0 = mfma8(a0, qr[0], negm); p1 = mfma8(a1, qr[0], negm); } else { p0 = mfma8(a0, qr[1], p0); p1 = mfma8(a1, qr[1], p1); } }
}
__device__ __forceinline__ void pv(f32x16* o, const LAS unsigned char* Vs, v8i pa, int r32, int hi) {
#pragma unroll
  for (int d0 = 0; d0 < 4; ++d0) { const int d = 32 * d0 + r32, sw = (d >> 2) & 3; const LAS unsigned char* rp = Vs + d * 64;
    const v8i bf = ld32(rp + 16 * ((2 * hi) ^ sw), rp + 16 * ((2 * hi + 1) ^ sw));
    o[d0] = mfma8(pa, bf, o[d0]); }
}

__device__ __forceinline__ void attn_body(const bf16_t* __restrict__ Qb, const unsigned char* __restrict__ K8h, const unsigned char* __restrict__ V8h,
                                          bf16_t* __restrict__ Ob, int NT, int s0, const float* __restrict__ qg,
                                          const float* __restrict__ ropec, const float* __restrict__ ropes, LAS unsigned char* lds) {
  int tid_o = threadIdx.x; asm volatile("" : "+v"(tid_o));
  const int tid = tid_o, wid = tid >> 6, lane = tid & 63, r32 = lane & 31, hi = lane >> 5;
  LAS unsigned char* V_lds = lds + LDS_V; LAS unsigned char* K_lds = lds + LDS_K;
  LAS float* ws = (LAS float*)(lds + LDS_WS) + wid * 64; LAS float* li_l = ws; LAS float* al_l = ws + 32;
  float mhat = 0.f, l_reg = 0; f32x16 o[4] = {}; v8i qr[2]; f32x16 negm; { float nb = PBIAS; asm volatile("" : "+v"(nb)); for (int r = 0; r < 16; ++r) negm[r] = nb; }
  {
    const unsigned char* Qw = (const unsigned char*)Qb + (long)(wid * QBLK + r32) * DM + hi * 32;
    u32x2 raw[2][4];
#pragma unroll
    for (int m = 0; m < 2; ++m)
#pragma unroll
      for (int c = 0; c < 4; ++c) raw[m][c] = *reinterpret_cast<const u32x2*>(Qw + 64 * m + 8 * c);
    float ss = 0.f;
#pragma unroll
    for (int m = 0; m < 2; ++m)
#pragma unroll
      for (int c = 0; c < 4; ++c)
#pragma unroll
        for (int d = 0; d < 2; ++d) { const auto pl = __builtin_amdgcn_cvt_pk_f32_fp8((int)raw[m][c][d], false); const auto ph = __builtin_amdgcn_cvt_pk_f32_fp8((int)raw[m][c][d], true); ss += (pl[0] * pl[0] + pl[1] * pl[1]) + (ph[0] * ph[0] + ph[1] * ph[1]); }
    { auto rr = __builtin_amdgcn_permlane32_swap(__float_as_uint(ss), __float_as_uint(ss), false, false); ss = __uint_as_float(rr[0]) + __uint_as_float(rr[1]); }
    const float rstd = (SCALE * 1.4426950408889634f) / sqrtf(ss * (1.f / 128.f) + EPS);
    const int s = s0 + wid * QBLK + r32, prow = s >> 6, pcol = s & 63;
#pragma unroll
    for (int m = 0; m < 2; ++m) { const int pos = m == 0 ? prow : pcol;
#pragma unroll
      for (int c = 0; c < 4; ++c) { const int f0 = 16 * hi + 4 * c, dd = 64 * m + 32 * hi + 8 * c;
        const f32x4 c4 = *reinterpret_cast<const f32x4*>(ropec + pos * 32 + f0), s4 = *reinterpret_cast<const f32x4*>(ropes + pos * 32 + f0);
        const f32x4 g0 = *reinterpret_cast<const f32x4*>(qg + dd), g1 = *reinterpret_cast<const f32x4*>(qg + dd + 4);
        float ov[8];
#pragma unroll
        for (int e = 0; e < 4; ++e) { const float gl = e < 2 ? g0[2 * e] : g1[2 * e - 4], gh = e < 2 ? g0[2 * e + 1] : g1[2 * e - 3];
          const auto prl = __builtin_amdgcn_cvt_pk_f32_fp8((int)raw[m][c][e >> 1], false); const auto prh = __builtin_amdgcn_cvt_pk_f32_fp8((int)raw[m][c][e >> 1], true);
          const float y0 = ((e & 1) ? prh[0] : prl[0]) * rstd * gl, y1 = ((e & 1) ? prh[1] : prl[1]) * rstd * gh;
          ov[2 * e] = y0 * c4[e] - y1 * s4[e]; ov[2 * e + 1] = y0 * s4[e] + y1 * c4[e]; }
        qr[m][2 * c] = (int)pk4_fp8(ov[0], ov[1], ov[2], ov[3]); qr[m][2 * c + 1] = (int)pk4_fp8(ov[4], ov[5], ov[6], ov[7]); } }
  }
  struct { u32x4 k0, v0, k1, v1; } st;
#define KSLOT(t) (K_lds + ((t) % NSLOT) * TILEB)
#define VSLOT(t) (V_lds + ((t) % NSLOT) * TILEB)
#define GLD(base, t) (*reinterpret_cast<const u32x4*>((base) + (size_t)(t) * TILEB + tid * 16))
#define PLOAD(t) do { if ((t) < NT) { st.k0 = GLD(K8h, (t)); st.v0 = GLD(V8h, (t)); } if ((t) + 1 < NT) { st.k1 = GLD(K8h, (t) + 1); st.v1 = GLD(V8h, (t) + 1); } } while (0)
#define PWRITE(t) do { if ((t) < NT) { *(LAS u32x4*)(KSLOT(t) + tid * 16) = st.k0; *(LAS u32x4*)(VSLOT(t) + tid * 16) = st.v0; } \
    if ((t) + 1 < NT) { *(LAS u32x4*)(KSLOT((t) + 1) + tid * 16) = st.k1; *(LAS u32x4*)(VSLOT((t) + 1) + tid * 16) = st.v1; } } while (0)
#define VMW0() asm volatile("s_waitcnt vmcnt(0)" ::: "memory")
#define RESC(a) do { if (__any((a) < 1.f)) { if (hi == 0) al_l[r32] = (a); asm volatile("s_waitcnt lgkmcnt(0)" ::: "memory"); \
    for (int d = 0; d < 4; ++d) for (int r = 0; r < 16; ++r) o[d][r] *= al_l[crow(r, hi)]; } } while (0)
  f32x16 pA0, pA1, pB0, pB1; float alA, alB; v8i pa;
  { const u32x4 k = GLD(K8h, 0), v = GLD(V8h, 0); VMW0(); *(LAS u32x4*)(KSLOT(0) + tid * 16) = k; *(LAS u32x4*)(VSLOT(0) + tid * 16) = v; }
  PLOAD(1); VMW0(); PWRITE(1);
  PLOAD(3);
  __syncthreads();
  qkt(pA0, pA1, KSLOT(0), qr, negm, r32, hi); partialSM<true>(pA0, pA1, mhat, negm, alA);
#pragma unroll 1
  for (int j = 1; j + 1 < NT; j += 2) {
    __syncthreads();
    VMW0(); PWRITE(j + 2); PLOAD(j + 4);
    SBAR(); qkt(pB0, pB1, KSLOT(j), qr, negm, r32, hi);
    finishSM(pA0, pA1, alA, l_reg, pa); SBAR();
    pv(o, VSLOT(j - 1), pa, r32, hi); partialSM<false>(pB0, pB1, mhat, negm, alB);
    RESC(alB);
    SBAR(); qkt(pA0, pA1, KSLOT(j + 1), qr, negm, r32, hi);
    finishSM(pB0, pB1, alB, l_reg, pa); SBAR();
    pv(o, VSLOT(j), pa, r32, hi); partialSM<false>(pA0, pA1, mhat, negm, alA);
    RESC(alA);
  }
  __syncthreads();
  SBAR(); qkt(pB0, pB1, KSLOT(NT - 1), qr, negm, r32, hi);
  finishSM(pA0, pA1, alA, l_reg, pa); SBAR();
  pv(o, VSLOT(NT - 2), pa, r32, hi); partialSM<false>(pB0, pB1, mhat, negm, alB);
  RESC(alB);
  finishSM(pB0, pB1, alB, l_reg, pa); SBAR();
  pv(o, VSLOT(NT - 1), pa, r32, hi);
  if (hi == 0) li_l[r32] = l_reg; asm volatile("s_waitcnt lgkmcnt(0)" ::: "memory");
  float rli[16];
#pragma unroll
  for (int r = 0; r < 16; ++r) rli[r] = __builtin_amdgcn_rcpf(li_l[crow(r, hi)]);
  unsigned char* Ow = (unsigned char*)Ob + (long)(wid * QBLK) * DM;
#pragma unroll
  for (int r = 0; r < 16; ++r) { int orow = crow(r, hi); const float sc = rli[r] * 32.0f;
    const unsigned w = pk4_fp8(o[0][r] * sc, o[1][r] * sc, o[2][r] * sc, o[3][r] * sc);
#pragma unroll
    for (int d0 = 0; d0 < 4; ++d0) Ow[(long)orow * DM + d0 * 32 + r32] = (unsigned char)((w >> (8 * d0)) & 0xffu); }
  __syncthreads();
#undef KSLOT
#undef VSLOT
#undef GLD
#undef PLOAD
#undef PWRITE
#undef VMW0
#undef RESC
}
#undef SBAR
}

#define XB_TMO      128
#define XB_XCNT(j)  (256  + 64 * (j))
#define XB_XSUB(j)  (1280 + 64 * (j))
#define XB_XGEN(j)  (2304 + 64 * (j))
#define XB_TOP      3328
#define XB_TOPGEN   3392
#define XCD_BAR_WORDS 3456
#define XB_SPIN_CAP (1u << 18)
__device__ __forceinline__ unsigned xb_ld(unsigned* p)              { return __hip_atomic_load(p, __ATOMIC_RELAXED, __HIP_MEMORY_SCOPE_AGENT); }
__device__ __forceinline__ unsigned xb_add(unsigned* p, unsigned v) { return __hip_atomic_fetch_add(p, v, __ATOMIC_RELAXED, __HIP_MEMORY_SCOPE_AGENT); }
__device__ __forceinline__ unsigned xb_xcc_id() { return (unsigned)__builtin_amdgcn_s_getreg((3 << 11) | 20) & 0xFu; }
#define XB_SPIN(cond, bar) do { unsigned _sp = 0; while (cond) { __builtin_amdgcn_s_sleep(1); \
    if ((++_sp & 255u) == 0u) { if (xb_ld(&(bar)[XB_TMO])) break; if (_sp > XB_SPIN_CAP) { atomicAdd(&(bar)[XB_TMO], 1u); break; } } } } while (0)
struct XcdBarrier { unsigned* bar; unsigned x; volatile LAS unsigned* st; };
__device__ __forceinline__ XcdBarrier xcd_barrier_post(unsigned* bar, volatile LAS unsigned* st) {
    XcdBarrier b; b.bar = bar; b.x = xb_xcc_id(); b.st = st;
    if (threadIdx.x == 0) (void)xb_add(&bar[XB_XCNT(b.x)], 1u);
    return b;
}
__device__ __forceinline__ void xcd_barrier_complete(unsigned* bar, unsigned x, unsigned& nloc, unsigned& nx) {
    const unsigned G = gridDim.x * gridDim.y * gridDim.z;
    unsigned sum, cnt, mine, sp = 0u;
    for (;;) {
        sum = 0u; cnt = 0u; mine = 0u;
#pragma unroll
        for (unsigned j = 0; j < 16; ++j) { const unsigned c = xb_ld(&bar[XB_XCNT(j)]); sum += c; cnt += (c > 0u) ? 1u : 0u; mine = (j == x) ? c : mine; }
        if (sum == G) break;
        __builtin_amdgcn_s_sleep(1);
        if ((++sp & 255u) == 0u) { if (xb_ld(&bar[XB_TMO])) break; if (sp > XB_SPIN_CAP) { atomicAdd(&bar[XB_TMO], 1u); break; } }
    }
    nloc = mine > 0u ? mine : 1u; nx = cnt > 0u ? cnt : 1u;
}
__device__ __forceinline__ void xcd_barrier(const XcdBarrier& b) {
    asm volatile("s_waitcnt vmcnt(0)" ::: "memory");
    __syncthreads();
    if (threadIdx.x == 0) {
        unsigned* bar = b.bar;
        __builtin_amdgcn_s_waitcnt(0);
        unsigned nloc = b.st[0], nx = b.st[1];
        if (nloc == 0u) { xcd_barrier_complete(bar, b.x, nloc, nx); b.st[0] = nloc; b.st[1] = nx; }
        const unsigned old = xb_add(&bar[XB_XSUB(b.x)], 1u);
        const unsigned gen = old / nloc;
        if (old + 1u == (gen + 1u) * nloc) {
            __builtin_amdgcn_fence(__ATOMIC_RELEASE, "agent");
            asm volatile("s_waitcnt vmcnt(0)" ::: "memory");
            const unsigned og = xb_add(&bar[XB_TOP], 1u);
            const unsigned tg = og / nx;
            if (og + 1u == (tg + 1u) * nx) xb_add(&bar[XB_TOPGEN], 1u);
            else XB_SPIN(xb_ld(&bar[XB_TOPGEN]) == tg, bar);
            __builtin_amdgcn_fence(__ATOMIC_ACQUIRE, "agent");
            xb_add(&bar[XB_XGEN(b.x)], 1u);
            asm volatile("s_waitcnt vmcnt(0)" ::: "memory");
        } else {
            XB_SPIN(xb_ld(&bar[XB_XGEN(b.x)]) == gen, bar);
            __builtin_amdgcn_fence(__ATOMIC_ACQUIRE, "agent");
            asm volatile("s_waitcnt vmcnt(0)" ::: "memory");
        }
    }
    __syncthreads();
}

struct Params {
    const float *x, *c, *ctx, *c_ctx, *ada_w, *ada_b, *norm_mix_g, *norm_mlp_g, *w_qkv, *qn_g, *kn_g, *attn_wo, *four_wo, *w1, *w2, *final_g;
    float* out; unsigned char* ws; int ph_lo, ph_hi;
};

template <bool F8 = false> __device__ __forceinline__ void transpose_item(const float* W, int K, int N, bf16_t* WT, LAS float* scr, int item, int lane) {
    const int nblk = N / 32, kb = item / nblk, nb = item % nblk, k0 = 64 * kb, n0 = 32 * nb;
#pragma unroll 8
    for (int i = 0; i < 32; ++i) { const int kk = 2 * i + (lane >> 5); scr[kk * 33 + (lane & 31)] = W[(size_t)(k0 + kk) * N + n0 + (lane & 31)]; }
    asm volatile("s_waitcnt lgkmcnt(0)" ::: "memory");
    const int c = lane & 7;
#pragma unroll
    for (int j = 0; j < 4; ++j) { const int n = (lane >> 3) + 8 * j; const LAS float* s = scr + (8 * c) * 33 + n;
        if constexpr (F8) { u32x2 o8; o8.x = pk4_fp8g(s[0 * 33] * 64.f, s[1 * 33] * 64.f, s[2 * 33] * 64.f, s[3 * 33] * 64.f); o8.y = pk4_fp8g(s[4 * 33] * 64.f, s[5 * 33] * 64.f, s[6 * 33] * 64.f, s[7 * 33] * 64.f);
            *(u32x2*)((unsigned char*)WT + (size_t)(n0 + n) * K + k0 + 8 * c) = o8; }
        else { u32x4 o; o.x = pk2(s[0 * 33], s[1 * 33]); o.y = pk2(s[2 * 33], s[3 * 33]); o.z = pk2(s[4 * 33], s[5 * 33]); o.w = pk2(s[6 * 33], s[7 * 33]);
            *(u32x4*)(WT + (size_t)(n0 + n) * K + k0 + 8 * c) = o; } }
    asm volatile("s_waitcnt lgkmcnt(0)" ::: "memory");
}

__device__ __forceinline__ void normmod_row(const float* xrow, const float* g, const float* sh, const float* sc, int lane, f32x4 (&y)[8]) {
    const f32x4* xr = (const f32x4*)xrow + lane; float s = 0.f;
#pragma unroll
    for (int j = 0; j < 8; ++j) { y[j] = xr[64 * j]; s += (y[j].x * y[j].x + y[j].y * y[j].y) + (y[j].z * y[j].z + y[j].w * y[j].w); }
    const float rstd = 1.0f / sqrtf(wave_sum(s) * (1.f / DM) + EPS);
#pragma unroll
    for (int j = 0; j < 8; ++j) { const f32x4 gg = ((const f32x4*)g)[lane + 64 * j], hh = ((const f32x4*)sh)[lane + 64 * j], cc = ((const f32x4*)sc)[lane + 64 * j];
        y[j] = y[j] * rstd * gg * (cc + 1.0f) + hh; }
}
struct RowMod { f32x4 gs[8], sh[8]; };
__device__ __forceinline__ void rowmod_load(RowMod& P, const float* g, const float* sh, const float* sc, int lane) {
#pragma unroll
    for (int j = 0; j < 8; ++j) { P.gs[j] = ((const f32x4*)g)[lane + 64 * j] * (((const f32x4*)sc)[lane + 64 * j] + 1.0f); P.sh[j] = ((const f32x4*)sh)[lane + 64 * j]; }
}
__device__ __forceinline__ void normmod_apply(f32x4 (&y)[8], float s, const RowMod& P) {
    const float rstd = 1.0f / sqrtf(wave_sum(s) * (1.f / DM) + EPS);
#pragma unroll
    for (int j = 0; j < 8; ++j) y[j] = y[j] * rstd * P.gs[j] + P.sh[j];
}
__device__ __forceinline__ void normmod_row_p(const float* xrow, const RowMod& P, int lane, f32x4 (&y)[8]) {
    const f32x4* xr = (const f32x4*)xrow + lane; float s = 0.f;
#pragma unroll
    for (int j = 0; j < 8; ++j) { y[j] = xr[64 * j]; s += (y[j].x * y[j].x + y[j].y * y[j].y) + (y[j].z * y[j].z + y[j].w * y[j].w); }
    normmod_apply(y, s, P);
}
__device__ __forceinline__ void normmod_row_bf_p(const bf16_t* xrow, const RowMod& P, int lane, f32x4 (&y)[8]) {
    const u32x2* xr = (const u32x2*)xrow + lane; float s = 0.f;
#pragma unroll
    for (int j = 0; j < 8; ++j) { const u32x2 w = xr[64 * j]; y[j] = (f32x4){bf_lo(w.x), bf_hi(w.x), bf_lo(w.y), bf_hi(w.y)}; s += (y[j].x * y[j].x + y[j].y * y[j].y) + (y[j].z * y[j].z + y[j].w * y[j].w); }
    normmod_apply(y, s, P);
}
__device__ __forceinline__ void normmod_row_bf(const bf16_t* xrow, const float* g, const float* sh, const float* sc, int lane, f32x4 (&y)[8]) {
    const u32x2* xr = (const u32x2*)xrow + lane; float s = 0.f;
#pragma unroll
    for (int j = 0; j < 8; ++j) { const u32x2 w = xr[64 * j]; y[j] = (f32x4){bf_lo(w.x), bf_hi(w.x), bf_lo(w.y), bf_hi(w.y)}; s += (y[j].x * y[j].x + y[j].y * y[j].y) + (y[j].z * y[j].z + y[j].w * y[j].w); }
    const float rstd = 1.0f / sqrtf(wave_sum(s) * (1.f / DM) + EPS);
#pragma unroll
    for (int j = 0; j < 8; ++j) { const f32x4 gg = ((const f32x4*)g)[lane + 64 * j], hh = ((const f32x4*)sh)[lane + 64 * j], cc = ((const f32x4*)sc)[lane + 64 * j];
        y[j] = y[j] * rstd * gg * (cc + 1.0f) + hh; }
}
__device__ __forceinline__ void store_row_fp8(unsigned char* orow, int lane, const f32x4 (&y)[8]) {
    unsigned* o4 = (unsigned*)orow + lane;
#pragma unroll
    for (int j = 0; j < 8; ++j) o4[64 * j] = pk4_fp8g(y[j].x, y[j].y, y[j].z, y[j].w);
}
__device__ __forceinline__ void store_row_bf16(bf16_t* orow, int lane, const f32x4 (&y)[8]) {
    u32x2* o8 = (u32x2*)orow + lane;
#pragma unroll
    for (int j = 0; j < 8; ++j) { u32x2 w; w.x = pk2(y[j].x, y[j].y); w.y = pk2(y[j].z, y[j].w); o8[64 * j] = w; }
}

__global__ void __launch_bounds__(512, 2) fwd_megakernel(Params p) {
    extern __shared__ __attribute__((aligned(16))) unsigned char lds[];
    LAS unsigned char* ldsl = (LAS unsigned char*)lds;
    const int tid = threadIdx.x, lane = tid & 63, wave = __builtin_amdgcn_readfirstlane(tid >> 6);
    const int G = gridDim.x, NGW = G * 8;
    unsigned char* ws = p.ws;
    float* mod = (float*)(ws + WS_MOD); float* ropec = (float*)(ws + WS_ROPE); float* ropes = ropec + 64 * 32;
    bf16_t* C256 = (bf16_t*)(ws + WS_C256); bf16_t* S256 = (bf16_t*)(ws + WS_S256);
    float* hny = (float*)(ws + WS_HNY); float* zfix = (float*)(ws + WS_ZFIX);
    bf16_t* Wqkv_t = (bf16_t*)(ws + WS_WQKV); bf16_t* Wo_t = (bf16_t*)(ws + WS_WO); bf16_t* Wf_t = (bf16_t*)(ws + WS_WF);
    bf16_t* Hb = (bf16_t*)(ws + WS_H); bf16_t* ACT = (bf16_t*)(ws + WS_ACT);
    bf16_t* Qb = (bf16_t*)(ws + WS_Q); bf16_t* Kb = (bf16_t*)(ws + WS_K); bf16_t* Vb = (bf16_t*)(ws + WS_V); bf16_t* Ob = (bf16_t*)(ws + WS_O);
    bf16_t* XB = (bf16_t*)(ws + WS_XB); bf16_t* Ub = (bf16_t*)(ws + WS_U); bf16_t* ZT = (bf16_t*)(ws + WS_ZT); bf16_t* Yb = (bf16_t*)(ws + WS_Y);
    const int lo = p.ph_lo, hi = p.ph_hi;
#ifndef PH_MASK
#define PH_MASK 0x1FFFF
#endif
#define INM(k, id) (((PH_MASK >> (id)) & 1) && lo <= (k) && (k) < hi)
#define IN(k) INM(k, k)
#ifndef PROBE_REPEAT
#define PROBE_REPEAT -1
#endif
#define REP(id) for (int rep_ = 0; rep_ < ((PROBE_REPEAT == (id)) ? 2 : 1); ++rep_)
#define SEAM(k) do { if (lo <= (k) && (k) + 1 < hi) xcd_barrier(xbar); } while (0)
    volatile LAS unsigned* misc = (volatile LAS unsigned*)(ldsl + LDS_MISC);
    if (tid < 4) misc[tid] = 0u;
    __syncthreads();
    XcdBarrier xbar; xbar.bar = (unsigned*)(ws + WS_CTL); xbar.x = 0; xbar.st = misc;
    if (hi - lo > 1) {
        unsigned* bar = xbar.bar; xbar.x = xb_xcc_id();
        if (tid == 0) {
            const unsigned rank = xb_add(&bar[XB_XCNT(xbar.x)], 1u);
            unsigned nloc, nx; xcd_barrier_complete(bar, xbar.x, nloc, nx); misc[0] = nloc; misc[1] = nx;
            bool uni = (nx == 8u) && (nloc * 8u == (unsigned)G) && (xbar.x < 8u) && (rank < nloc);
#pragma unroll
            for (unsigned j = 0; j < 16; ++j) { const unsigned c = xb_ld(&bar[XB_XCNT(j)]); if (j < 8 ? (c * 8u != (unsigned)G) : (c != 0u)) uni = false; }
            misc[2] = uni ? (rank * 8u + xbar.x + 1u) : 0u;
        }
        __syncthreads();
    }
    const unsigned vw_ = misc[2];
    const int wg = __builtin_amdgcn_readfirstlane(vw_ ? (int)(vw_ - 1u) : (int)blockIdx.x);
    const int gw = wg * 8 + wave;
    if (lo == -12345) cg::this_grid().sync();

    REP(0) if (IN(0)) {
        {
            LAS float* scr = (LAS float*)(ldsl + wave * 16384);
            constexpr int I_QKV = (DM / 64) * (QKVD / 32), I_O = (DM / 64) * (DM / 32), I_1 = (DM / 64) * (DFF / 32), I_2 = (DFF / 64) * (DM / 32);
            constexpr int NITEMS = I_QKV + 2 * I_O + 2 * I_1 + 2 * I_2;
            for (int it = gw; it < NITEMS; it += NGW) {
                int r = it;
                if (r < I_QKV) { transpose_item<true>(p.w_qkv, DM, QKVD, Wqkv_t, scr, r, lane); continue; } r -= I_QKV;
                if (r < I_O) { transpose_item<true>(p.attn_wo, DM, DM, Wo_t, scr, r, lane); continue; } r -= I_O;
                if (r < I_O) { transpose_item(p.four_wo, DM, DM, Wf_t, scr, r, lane); continue; } r -= I_O;
                if (r < I_1) { transpose_item(p.w1, DM, DFF, (bf16_t*)(ws + WS_W1A), scr, r, lane); continue; } r -= I_1;
                if (r < I_1) { transpose_item(p.w1 + (size_t)DM * DFF, DM, DFF, (bf16_t*)(ws + WS_W1B), scr, r, lane); continue; } r -= I_1;
                if (r < I_2) { transpose_item(p.w2, DFF, DM, (bf16_t*)(ws + WS_W2A), scr, r, lane); continue; } r -= I_2;
                transpose_item(p.w2 + (size_t)DM * DFF, DFF, DM, (bf16_t*)(ws + WS_W2B), scr, r, lane);
            }
        }
        __syncthreads();
        {
            LAS float* tab = (LAS float*)ldsl;
            for (int m = tid; m < 4096; m += 512) tab[m] = cospif((float)m * (1.0f / 2048.0f)) * (1.0f / 64.0f);
            __syncthreads();
            bf16_t* Tc = (bf16_t*)(ws + WS_T); bf16_t* Ts = (bf16_t*)(ws + WS_T + 8 * MiB);
            for (int k = wg; k < 2048; k += G) {
                const int j0 = (tid * 8) & 2047; const bool sn = tid >= 256; float v[8];
#pragma unroll
                for (int e = 0; e < 8; ++e) v[e] = tab[((k * (j0 + e)) + (sn ? 3072 : 0)) & 4095];
                u32x4 w; w.x = pk2(v[0], v[1]); w.y = pk2(v[2], v[3]); w.z = pk2(v[4], v[5]); w.w = pk2(v[6], v[7]);
                *(u32x4*)((sn ? Ts : Tc) + (size_t)k * 2048 + j0) = w;
            }
            __syncthreads();
        }
        {
            for (int idx = wg * 512 + tid; idx < 2 * 65536; idx += G * 512) {
                const int which = idx >> 16, e = idx & 65535, kc = e >> 8, cc = e & 255; const float a = (float)((kc * cc) & 255) * (1.0f / 128.0f);
                const float v = (which ? sinpif(a) : cospif(a)) * (1.0f / 16.0f);
                (which ? S256 : C256)[e] = (bf16_t)f2bf(v);
            }
            for (int idx = wg * 512 + tid; idx < 2048; idx += G * 512) {
                const int pos = idx >> 5, f = idx & 31; const float inv = powf(10000.0f, -(float)f / 32.0f), ang = (float)pos * inv;
                ropec[idx] = cosf(ang); ropes[idx] = sinf(ang);
            }
        }
        for (int un = wg; un < 192; un += G) {
            const int l = un / 96, cb = un % 96;
            LAS float* sl = (LAS float*)ldsl;
            LAS float* red = (LAS float*)(ldsl + 65536);
            __syncthreads();
            for (int i = tid; i < DM * 5; i += 512) { const int k = i / 5, r = i % 5; const float v = r < 4 ? p.c[r * DM + k] : p.c_ctx[k]; sl[i] = v / (1.0f + __expf(-v)); }
            __syncthreads();
            const int hw = tid >> 5, l32 = tid & 31;
            const float* wp = p.ada_w + (size_t)l * DM * NMOD + cb * 128 + l32 * 4;
            f32x4 a0 = {0, 0, 0, 0}, a1 = a0, a2 = a0, a3 = a0, a4 = a0;
#pragma unroll 8
            for (int kk = 0; kk < 128; ++kk) { const int k = kk * 16 + hw; const f32x4 w = *(const f32x4*)(wp + (size_t)k * NMOD);
                const LAS float* s = sl + k * 5; a0 += w * s[0]; a1 += w * s[1]; a2 += w * s[2]; a3 += w * s[3]; a4 += w * s[4]; }
            *(LAS f32x4*)(red + (hw * 5 + 0) * 128 + l32 * 4) = a0; *(LAS f32x4*)(red + (hw * 5 + 1) * 128 + l32 * 4) = a1; *(LAS f32x4*)(red + (hw * 5 + 2) * 128 + l32 * 4) = a2;
            *(LAS f32x4*)(red + (hw * 5 + 3) * 128 + l32 * 4) = a3; *(LAS f32x4*)(red + (hw * 5 + 4) * 128 + l32 * 4) = a4;
            __syncthreads();
            for (int idx = tid; idx < 640; idx += 512) { const int r = idx >> 7, cc = idx & 127; float sum = p.ada_b[l * NMOD + cb * 128 + cc];
#pragma unroll
                for (int h = 0; h < 16; ++h) sum += red[(h * 5 + r) * 128 + cc];
                mod[(size_t)(l * 5 + r) * NMOD + cb * 128 + cc] = sum; }
        }
    }
    SEAM(0);

    REP(1) if (IN(1)) {
        const int rpw = (MLAT + NGW - 1) / NGW;
        { RowMod P; int bl = -1;
          for (int m = gw * rpw; m < (gw + 1) * rpw && m < MLAT; ++m) { const int r = m / SEQ;
            if (r != bl) { rowmod_load(P, p.norm_mix_g, mod + (size_t)r * NMOD, mod + (size_t)r * NMOD + DM, lane); bl = r; }
            f32x4 y[8]; normmod_row_p(p.x + (size_t)m * DM, P, lane, y);
            store_row_fp8((unsigned char*)Hb + (size_t)m * DM, lane, y); } }
        { RowMod P; rowmod_load(P, p.norm_mix_g, mod + (size_t)4 * NMOD, mod + (size_t)4 * NMOD + DM, lane);
          for (int m = gw; m < MCTX; m += NGW) { f32x4 y[8]; normmod_row_p(p.ctx + (size_t)m * DM, P, lane, y);
            store_row_fp8((unsigned char*)Hb + (size_t)(MLAT + m) * DM, lane, y); } }
    }
    SEAM(1);

    REP(2) if (IN(2)) {
        pg8::SchedQKV S{(const char*)Hb, (const char*)Wqkv_t, G, wg};
        pg8::EpiBf16<0> E{Qb, Kb, Vb, DM, KVD, 1};
        pg8::gemm_phase_t<true, 0x79797979, 0x7f7f7f7f>(ldsl, DM / 128, DM, DM, S, E);
    }
    SEAM(2);

    if (IN(3)) {
        unsigned char* K8 = ws + WS_K8; unsigned char* V8 = ws + WS_V8;
        LAS unsigned char* vt = ldsl + wave * 8192;
        const int l16 = lane & 15, kq = lane >> 4, d0 = l16 * 8;
        const f32x4 g0 = *(const f32x4*)(p.kn_g + d0), g1 = *(const f32x4*)(p.kn_g + d0 + 4);
        for (int un = gw; un < NB * NKV * (SKV / 64); un += NGW) {
            const int tile = un % (SKV / 64), bh = un / (SKV / 64), b = bh / NKV, head = bh % NKV;
            const size_t tb = (size_t)un * 8192;
#pragma unroll 1
            for (int bt = 0; bt < 4; ++bt) {
                u32x4 rawk[4], rawvv[4]; f32x4 c4s[4], s4s[4];
                const bool lat = tile * 64 < SEQ;
                const int i0 = l16 * 4, f0 = i0 & 31;
#pragma unroll
                for (int q = 0; q < 4; ++q) { const int i = (bt * 4 + q) * 4 + kq, j = tile * 64 + i; const size_t src = ((size_t)(b * SKV + j)) * KVD + head * HD + d0;
                    rawk[q] = *(const u32x4*)(Kb + src); rawvv[q] = *(const u32x4*)(Vb + src);
                    if (lat) { const int pos = i0 < 32 ? tile : i; c4s[q] = *(const f32x4*)(ropec + pos * 32 + f0); s4s[q] = *(const f32x4*)(ropes + pos * 32 + f0); } }
                asm volatile("" ::: "memory");
#pragma unroll
                for (int q = 0; q < 4; ++q) { const int i = (bt * 4 + q) * 4 + kq; const u32x4 raw = rawk[q], rawv = rawvv[q];
                    float v[8];
#pragma unroll
                    for (int e = 0; e < 4; ++e) { v[2 * e] = bf_lo(raw[e]); v[2 * e + 1] = bf_hi(raw[e]); }
                    float ss = 0.f;
#pragma unroll
                    for (int e = 0; e < 8; ++e) ss += v[e] * v[e];
                    ss += __shfl_xor(ss, 1); ss += __shfl_xor(ss, 2); ss += __shfl_xor(ss, 4); ss += __shfl_xor(ss, 8);
                    const float rstd = 1.0f / sqrtf(ss * (1.f / 128.f) + EPS);
#pragma unroll
                    for (int e = 0; e < 4; ++e) { v[e] *= rstd * g0[e]; v[4 + e] *= rstd * g1[e]; }
                    if (lat) { const f32x4 c4 = c4s[q], s4 = s4s[q];
#pragma unroll
                        for (int e = 0; e < 4; ++e) { const float y0 = v[2 * e], y1 = v[2 * e + 1]; v[2 * e] = y0 * c4[e] - y1 * s4[e]; v[2 * e + 1] = y0 * s4[e] + y1 * c4[e]; } }
                    { u32x2 w; w.x = att8::pk4_fp8(v[0], v[1], v[2], v[3]); w.y = att8::pk4_fp8(v[4], v[5], v[6], v[7]);
                      *(u32x2*)(K8 + tb + i * 128 + 16 * ((d0 >> 4) ^ ((i >> 1) & 7)) + (d0 & 15)) = w; }
                    { const int slot = ((i >> 2) & 1) * 32 + (i & 3) + 4 * ((i & 31) >> 3) + 16 * (i >> 5);
                      const unsigned w0 = att8::pk4_fp8(bf_lo(rawv[0]), bf_hi(rawv[0]), bf_lo(rawv[1]), bf_hi(rawv[1])), w1 = att8::pk4_fp8(bf_lo(rawv[2]), bf_hi(rawv[2]), bf_lo(rawv[3]), bf_hi(rawv[3]));
#pragma unroll
                      for (int e = 0; e < 8; ++e) { const int d = d0 + e; const unsigned by = ((e < 4 ? w0 : w1) >> (8 * (e & 3))) & 0xffu;
                          vt[d * 64 + 16 * ((slot >> 4) ^ ((d >> 2) & 3)) + (slot & 15)] = (unsigned char)by; } }
                }
            }
            asm volatile("s_waitcnt lgkmcnt(0)" ::: "memory");
#pragma unroll
            for (int q = 0; q < 8; ++q) *(u32x4*)(V8 + tb + (q * 64 + lane) * 16) = *(const LAS u32x4*)(vt + (q * 64 + lane) * 16);
            asm volatile("s_waitcnt lgkmcnt(0)" ::: "memory");
        }
    }
    SEAM(3);

    REP(4) if (IN(4)) {
        const int nper = G / 8;
        const int xcd = wg % 8, wl = wg / 8;
        for (int idx = wl; idx < 128; idx += nper) {
            const int grp = xcd + 8 * (idx / 64), b = grp / NKV, kvh = grp % NKV, ui = idx % 64, h = kvh * 4 + ui / 16, qb = ui % 16;
            const bf16_t* q = (const bf16_t*)((const unsigned char*)Qb + ((size_t)(b * SEQ + qb * 256)) * DM + h * HD);
            const unsigned char* k8 = ws + WS_K8 + (size_t)((b * NKV + kvh) * (SKV / 64)) * 8192; const unsigned char* v8 = ws + WS_V8 + (size_t)((b * NKV + kvh) * (SKV / 64)) * 8192;
            bf16_t* o = (bf16_t*)((unsigned char*)Ob + ((size_t)(b * SEQ + qb * 256)) * DM + h * HD);
            att8::attn_body(q, k8, v8, o, SKV / 64, qb * 256, p.qn_g, ropec, ropes, ldsl);
        }
    }
    SEAM(4);

    if (IN(5)) {
        pg8::SchedStd S{(const char*)Ob, (const char*)Wo_t, MLAT / 256, DM / 256, G, wg, (size_t)256 * DM, (size_t)256 * DM};
        pg8::EpiResid<false> E{p.x, XB, mod + 2 * DM};
        pg8::gemm_phase_t<true, 0x79797979, 0x7a7a7a7a>(ldsl, DM / 128, DM, DM, S, E);
    }
    SEAM(5);

#define MLP_BLOCK(l, pb) do { \
    if (INM(pb, 6)) { \
        const int rpw = (MLAT + NGW - 1) / NGW; RowMod P; int bl = -1; \
        for (int m = gw * rpw; m < (gw + 1) * rpw && m < MLAT; ++m) { const int r = m / SEQ; \
            if (r != bl) { rowmod_load(P, p.norm_mlp_g + l * DM, mod + (size_t)(l * 5 + r) * NMOD + 3 * DM, mod + (size_t)(l * 5 + r) * NMOD + 4 * DM, lane); bl = r; } \
            f32x4 y[8]; normmod_row_bf_p(XB + (size_t)m * DM, P, lane, y); \
            store_row_bf16(Hb + (size_t)m * DM, lane, y); \
        } \
    } \
    SEAM(pb); \
    REP(7 + 100 * l) if (INM(pb + 1, 7)) { \
        pg8::SchedStd S{(const char*)Hb, (const char*)(ws + (l == 0 ? WS_W1A : WS_W1B)), MLAT / 256, DFF / 256, G, wg, (size_t)256 * DM * 2, (size_t)256 * DM * 2}; \
        pg8::EpiBf16<1> E{ACT, ACT, ACT, DFF, DFF}; \
        pg8::gemm_phase(ldsl, DM, DM, DM, S, E); \
    } \
    SEAM(pb + 1); \
    if (INM(pb + 2, 8)) { \
        pg8::SchedStd S{(const char*)ACT, (const char*)(ws + (l == 0 ? WS_W2A : WS_W2B)), MLAT / 256, DM / 256, G, wg, (size_t)256 * DFF * 2, (size_t)256 * DFF * 2, 4}; \
        pg8::EpiResid<true> E{nullptr, XB, mod + (size_t)l * 5 * NMOD + 5 * DM}; \
        pg8::gemm_phase(ldsl, DFF, DFF, DFF, S, E); \
    } \
    SEAM(pb + 2); \
    } while (0)
    MLP_BLOCK(0, 6);
    if (IN(9)) {
        RowMod P; int bl = -1;
        for (int t = gw; t < NB * 2049; t += NGW) {
            const int b = t & 3, n = t >> 2;
            if (b != bl) { rowmod_load(P, p.norm_mix_g + DM, mod + (size_t)(5 + b) * NMOD, mod + (size_t)(5 + b) * NMOD + DM, lane); bl = b; }
            f32x4 y[8]; normmod_row_bf_p(XB + ((size_t)b * SEQ + n) * DM, P, lane, y);
            if (n == 0) store_row_bf16(Ub + ((size_t)b * SEQ) * DM, lane, y);
            else if (n == 2048) {
#pragma unroll
                for (int j = 0; j < 8; ++j) { ((f32x4*)(hny + b * DM))[lane + 64 * j] = y[j]; y[j] = (f32x4){0.f, 0.f, 0.f, 0.f}; }
                store_row_bf16(Ub + ((size_t)b * SEQ + 2048) * DM, lane, y);
            } else {
                f32x4 z[8]; normmod_row_bf_p(XB + ((size_t)b * SEQ + (SEQ - n)) * DM, P, lane, z);
                f32x4 sm[8];
#pragma unroll
                for (int j = 0; j < 8; ++j) { sm[j] = y[j] + z[j]; z[j] = y[j] - z[j]; }
                store_row_bf16(Ub + ((size_t)b * SEQ + n) * DM, lane, sm);
                store_row_bf16(Ub + ((size_t)b * SEQ + 2048 + n) * DM, lane, z);
            }
        }
    }
    SEAM(9);
    REP(10) if (IN(10)) {
        for (int un = wg; un < 32; un += G) {
            LAS float* hrow = (LAS float*)(ldsl + 131072); LAS float* ctab = hrow + 256;
            const int b = un >> 3, g = un & 7;
            __syncthreads();
            if (tid < 256) { hrow[tid] = hny[b * DM + g * 256 + tid]; ctab[tid] = cospif((float)tid * (1.0f / 128.0f)) * (1.0f / 16.0f); }
            __syncthreads();
            const int kc = tid >> 1, c0 = (tid & 1) * 128; float s = 0.f;
            for (int cc = c0; cc < c0 + 128; ++cc) s += ctab[(kc * cc) & 255] * hrow[cc];
            s += __shfl_xor(s, 1);
            if ((tid & 1) == 0) zfix[b * DM + g * 256 + kc] = s;
        }
        __syncthreads();
        pg8::SchedChan S{(const char*)C256, (const char*)S256, (const char*)Ub, G, wg};
        pg8::EpiBf16<0> E{ZT, ZT, ZT, 4096, 4096};
        pg8::gemm_phase(ldsl, 256, 256, DM, S, E);
    }
    SEAM(10);
    REP(11) if (IN(11)) {
        for (int r = gw; r < NB * DM; r += NGW) {
            const u32x4* zr = (const u32x4*)(ZT + (size_t)r * 4096) + lane; float sacc = 0.f;
#pragma unroll
            for (int q = 0; q < 4; ++q) { const u32x4 w = zr[64 * q];
#pragma unroll
                for (int e = 0; e < 4; ++e) sacc += bf_lo(w[e]) - bf_hi(w[e]); }
            sacc = wave_sum(sacc);
            if (lane == 0) Yb[((size_t)(r >> 11) * SEQ + 2048) * DM + (r & 2047)] = (bf16_t)f2bf((sacc + zfix[r]) * (1.0f / 64.0f));
        }
        pg8::SchedSeq2 S{(const char*)(ws + WS_T), (const char*)ZT, G, wg};
        pg8::EpiSeq2 E{Yb, (bf16_t*)(ws + WS_PT), zfix};
        pg8::gemm_phase(ldsl, 2048, 2048, 4096, S, E);
    }
    SEAM(11);
    if (IN(12)) {
        pg8::SchedStd S{(const char*)Yb, (const char*)Wf_t, MLAT / 256, DM / 256, G, wg, (size_t)256 * DM * 2, (size_t)256 * DM * 2};
        pg8::EpiResid<true> E{nullptr, XB, mod + (size_t)5 * NMOD + 2 * DM};
        pg8::gemm_phase(ldsl, DM, DM, DM, S, E);
    }
    SEAM(12);
    MLP_BLOCK(1, 13);
    if (IN(16)) {
        f32x4 fg[8];
#pragma unroll
        for (int j = 0; j < 8; ++j) fg[j] = ((const f32x4*)p.final_g)[lane + 64 * j];
        for (int m = gw; m < MLAT; m += NGW) {
            const u32x2* xr = (const u32x2*)(XB + (size_t)m * DM) + lane; f32x4* orow = (f32x4*)(p.out + (size_t)m * DM) + lane; f32x4 y[8]; float s = 0.f;
#pragma unroll
            for (int j = 0; j < 8; ++j) { const u32x2 w = xr[64 * j]; y[j] = (f32x4){bf_lo(w.x), bf_hi(w.x), bf_lo(w.y), bf_hi(w.y)}; s += (y[j].x * y[j].x + y[j].y * y[j].y) + (y[j].z * y[j].z + y[j].w * y[j].w); }
            const float rstd = 1.0f / sqrtf(wave_sum(s) * (1.f / DM) + EPS);
#pragma unroll
            for (int j = 0; j < 8; ++j) orow[64 * j] = y[j] * rstd * fg[j];
        }
    }
#undef IN
#undef INM
#undef SEAM
}

extern "C" void kernel_launch(void* const* d_in, const int* in_sizes, int n_in, void* d_out, int out_size, void* d_ws, size_t ws_size, hipStream_t stream) {
    static int grid = 0;
    if (grid == 0) {
        if (n_in != 16 || out_size != MLAT * DM || ws_size < WS_END) { fprintf(stderr, "kernel_launch: unexpected shapes (n_in %d out %d ws %zu)\n", n_in, out_size, ws_size); grid = -1; return; }
        int dev = 0, cus = 0, per_cu = 0;
        hipGetDevice(&dev); hipDeviceGetAttribute(&cus, hipDeviceAttributeMultiprocessorCount, dev);
        if (hipFuncSetAttribute((const void*)fwd_megakernel, hipFuncAttributeMaxDynamicSharedMemorySize, LDS_BYTES) != hipSuccess) { fprintf(stderr, "kernel_launch: hipFuncSetAttribute failed\n"); grid = -1; return; }
        if (hipOccupancyMaxActiveBlocksPerMultiprocessor(&per_cu, (const void*)fwd_megakernel, 512, LDS_BYTES) != hipSuccess || per_cu < 1) { fprintf(stderr, "kernel_launch: occupancy query says %d\n", per_cu); per_cu = 1; }
        (void)hipGetLastError();
        grid = cus * 1;
        if (grid % 8 != 0 || grid <= 0) { fprintf(stderr, "kernel_launch: unexpected CU count %d\n", cus); grid = -1; return; }
    }
    if (grid < 0) return;
    Params p{};
    p.x = (const float*)d_in[0]; p.c = (const float*)d_in[1]; p.ctx = (const float*)d_in[2]; p.c_ctx = (const float*)d_in[3];
    p.ada_w = (const float*)d_in[4]; p.ada_b = (const float*)d_in[5]; p.norm_mix_g = (const float*)d_in[6]; p.norm_mlp_g = (const float*)d_in[7];
    p.w_qkv = (const float*)d_in[8]; p.qn_g = (const float*)d_in[9]; p.kn_g = (const float*)d_in[10]; p.attn_wo = (const float*)d_in[11];
    p.four_wo = (const float*)d_in[12]; p.w1 = (const float*)d_in[13]; p.w2 = (const float*)d_in[14]; p.final_g = (const float*)d_in[15];
    p.out = (float*)d_out; p.ws = (unsigned char*)d_ws;
#if MK_MULTI_LAUNCH
    for (int ph = 0; ph < NPHASE; ++ph) {
        p.ph_lo = ph; p.ph_hi = ph + 1;
        hipLaunchKernelGGL(fwd_megakernel, dim3(grid), dim3(512), LDS_BYTES, stream, p);
    }
#else
    p.ph_lo = 0; p.ph_hi = NPHASE;
    if (hipMemsetAsync((char*)d_ws + WS_CTL, 0, CTL_ZERO_BYTES, stream) != hipSuccess) { fprintf(stderr, "kernel_launch: memset failed\n"); return; }
    void* args[] = {&p};
    hipError_t e = hipLaunchCooperativeKernel((const void*)fwd_megakernel, dim3(grid), dim3(512), args, LDS_BYTES, stream);
    if (e != hipSuccess) fprintf(stderr, "kernel_launch: cooperative launch failed: %s (grid %d)\n", hipGetErrorString(e), grid);
#endif
}
```
